# Optimizing an MI355X kernel written in HIP

```python
import jax, jax.numpy as jnp
from jax import lax
import numpy as np

D_MODEL = 2048
BATCH = 8
SEQ = 4096
DEPTH = 4

MIX_W = D_MODEL
ATT_W = MIX_W // 2
HEAD_DIM = 128
N_ATT_HEADS = ATT_W // HEAD_DIM
CONV_W = MIX_W // 4
CONV_TAPS = 3
POOL_W = MIX_W - ATT_W - CONV_W
POOL_WINDOWS = (2, 4, 8, 16)
POOL_GROUP = POOL_W // len(POOL_WINDOWS)
Q_BLOCK = 128
LN_EPS = 1e-5
DEEPNORM_ALPHA = (2 * DEPTH) ** 0.25
DEEPNORM_BETA = (8 * DEPTH) ** -0.25

IN_WIDTHS = (ATT_W, ATT_W, ATT_W, ATT_W, N_ATT_HEADS,
             CONV_W, CONV_W, CONV_W, CONV_W, POOL_W, POOL_W)
IN_W = sum(IN_WIDTHS)
IN_SPLITS = tuple(sum(IN_WIDTHS[:i + 1]) for i in range(len(IN_WIDTHS) - 1))

kernel_name = "hybrid_fox_shortconv_pool_deepnorm"


def layer_norm(x, g, b):
    x32 = x.astype(jnp.float32)
    mu = jnp.mean(x32, axis=-1, keepdims=True)
    var = jnp.mean(jnp.square(x32 - mu), axis=-1, keepdims=True)
    return ((x32 - mu) * lax.rsqrt(var + LN_EPS) * g + b).astype(x.dtype)


def forgetting_attention(q, k, v, fg_logit, b_f):
    b, s, h, dh = q.shape
    nb = s // Q_BLOCK
    log_f = jax.nn.log_sigmoid(fg_logit.astype(jnp.float32) + b_f.astype(jnp.float32))
    cum = jnp.cumsum(log_f, axis=1)
    cum_k = jnp.transpose(cum, (0, 2, 1))
    q_blocks = q.reshape(b, nb, Q_BLOCK, h, dh).transpose(1, 0, 2, 3, 4)
    c_blocks = cum.reshape(b, nb, Q_BLOCK, h).transpose(1, 0, 3, 2)
    k_pos = jnp.arange(s)
    scale = HEAD_DIM ** -0.5

    def block(args):
        qb, cb, i = args
        logits = jnp.einsum('bqhd,bkhd->bhqk', qb, k).astype(jnp.float32) * scale
        logits = logits + cb[..., None] - cum_k[:, :, None, :]
        q_pos = i * Q_BLOCK + jnp.arange(Q_BLOCK)
        causal = k_pos[None, :] <= q_pos[:, None]
        logits = jnp.where(causal, logits, -jnp.inf)
        p = jax.nn.softmax(logits, axis=-1).astype(v.dtype)
        return jnp.einsum('bhqk,bkhd->bqhd', p, v)

    out = lax.map(block, (q_blocks, c_blocks, jnp.arange(nb)))
    return out.transpose(1, 0, 2, 3, 4).reshape(b, s, h * dh)


def short_conv_mixer(gate_b, gate_c, h, conv_w):
    s = h.shape[1]
    u = gate_c * h
    up = jnp.pad(u, ((0, 0), (CONV_TAPS - 1, 0), (0, 0)))
    y = conv_w[0] * up[:, 0:s]
    for j in range(1, CONV_TAPS):
        y = y + conv_w[j] * up[:, j:j + s]
    return gate_b * y


def multiscale_pool_mixer(u, pool_w, pool_scale):
    s = u.shape[1]
    u32 = u.astype(jnp.float32)
    cs = jnp.pad(jnp.cumsum(u32, axis=1), ((0, 0), (1, 0), (0, 0)))
    t1 = jnp.arange(1, s + 1, dtype=jnp.float32)
    outs = []
    for g, w in enumerate(POOL_WINDOWS):
        sl = slice(g * POOL_GROUP, (g + 1) * POOL_GROUP)
        csg = cs[:, :, sl]
        lagged = jnp.pad(csg[:, :s - w + 1], ((0, 0), (w - 1, 0), (0, 0)))
        count = jnp.minimum(t1, float(w))
        mean = (csg[:, 1:] - lagged) / count[None, :, None]
        z = (mean - u32[:, :, sl]).astype(u.dtype)
        outs.append(jnp.einsum('bsc,cd->bsd', z, pool_w[g]))
    return jnp.concatenate(outs, axis=-1) * pool_scale


def setup_inputs(seed: int = 0) -> dict:
    key = jax.random.key(seed)
    ks = jax.random.split(key, 10)
    x = jax.random.normal(ks[0], (BATCH, SEQ, D_MODEL), jnp.float32)
    w_in = jax.random.normal(ks[1], (DEPTH, D_MODEL, IN_W), jnp.float32) * D_MODEL ** -0.5
    b_f = jax.random.uniform(ks[2], (DEPTH, N_ATT_HEADS), jnp.float32, 1.0, 4.0)
    conv_w = jax.random.normal(ks[3], (DEPTH, CONV_TAPS, CONV_W), jnp.float32) * CONV_TAPS ** -0.5
    pool_w = jax.random.normal(ks[4], (DEPTH, len(POOL_WINDOWS), POOL_GROUP, POOL_GROUP),
                               jnp.float32) * POOL_GROUP ** -0.5
    pool_scale = 1.0 + 0.1 * jax.random.normal(ks[5], (DEPTH, POOL_W), jnp.float32)
    w_out = jax.random.normal(ks[6], (DEPTH, MIX_W, D_MODEL), jnp.float32) * (
        MIX_W ** -0.5 * DEEPNORM_BETA)
    ln_g = 1.0 + 0.1 * jax.random.normal(ks[7], (DEPTH, D_MODEL), jnp.float32)
    ln_b = 0.02 * jax.random.normal(ks[8], (DEPTH, D_MODEL), jnp.float32)
    return {"x": x, "w_in": w_in, "b_f": b_f, "conv_w": conv_w, "pool_w": pool_w,
            "pool_scale": pool_scale, "w_out": w_out, "ln_g": ln_g, "ln_b": ln_b}


def reference(x, w_in, b_f, conv_w, pool_w, pool_scale, w_out, ln_g, ln_b):
    b, s, _ = x.shape
    for l in range(DEPTH):
        proj = jnp.einsum('bsd,de->bse', x, w_in[l])
        (q, k, v, g_att, fg, c_b, c_c, c_h, g_conv, p_u, g_pool) = jnp.split(
            proj, IN_SPLITS, axis=-1)
        heads = (b, s, N_ATT_HEADS, HEAD_DIM)
        y_att = forgetting_attention(q.reshape(heads), k.reshape(heads), v.reshape(heads),
                                     fg, b_f[l]) * jax.nn.silu(g_att)
        y_conv = short_conv_mixer(c_b, c_c, c_h, conv_w[l]) * jax.nn.silu(g_conv)
        y_pool = multiscale_pool_mixer(p_u, pool_w[l], pool_scale[l]) * jax.nn.silu(g_pool)
        y = jnp.concatenate([y_att, y_conv, y_pool], axis=-1)
        y = jnp.einsum('bse,ed->bsd', y, w_out[l])
        x = layer_norm(DEEPNORM_ALPHA * x + y, ln_g[l], ln_b[l])
    return x
```

```cpp
#include <hip/hip_runtime.h>
#include <hip/hip_bf16.h>
#include <hip/hip_cooperative_groups.h>
#include <cstdio>
#include <cstdint>
namespace cg = cooperative_groups;

#ifndef MK_MULTI_LAUNCH
#define MK_MULTI_LAUNCH 0
#endif

namespace pg8 {
#define PG8_LAS __attribute__((address_space(3)))
typedef unsigned short bf16_t;
typedef short bf16x8 __attribute__((ext_vector_type(8)));
typedef float f32x4 __attribute__((ext_vector_type(4)));
typedef unsigned u32x4 __attribute__((ext_vector_type(4)));
constexpr int BM = 256, BK = 64, HALF = 128, HTB = HALF * BK * 2  , STAGE_BYTES = 8 * HTB, NXCD = 8, WGM = 8;

__host__ __device__ __forceinline__ int lds_byte(int r, int c) { const int st = (r >> 4) * 2 + (c >> 5), rr = r & 15, cc = c & 31, ob = rr * 64 + cc * 2; return st * 1024 + (ob ^ (((ob >> 9) & 1) << 5)); }
__host__ __device__ __forceinline__ void stage_rc(int b, int& R, int& C) { const int st = b / 1024, sb = b % 1024, swz = sb ^ (((sb >> 9) & 1) << 5); R = (st >> 1) * 16 + swz / 64; C = (st & 1) * 32 + (swz % 64) / 2; }
__host__ __device__ __forceinline__ int perm32(int rho) { const int n = rho >> 4, i = rho & 15; return 8 * (i >> 2) + 4 * n + (i & 3); }

struct Unit { int pm, pn; };
struct Gemm { const bf16_t* A; const bf16_t* Bt; int M, N, K; };

struct StaticOrder {
    int nM, nN, nwg, G, c;
    __host__ __device__ void init(int M, int N, int G_, int c_) { nM = M / BM; nN = N / BM; nwg = nM * nN; G = G_; c = c_; }
    __host__ __device__ bool next(int i, Unit& u) const {
        const long L = (long)i * G + c; if (L >= nwg) return false;
        int wgid = (int)L; { const int q = nwg / NXCD, r = nwg % NXCD, xcd = wgid % NXCD, off = wgid / NXCD; wgid = (xcd < r ? xcd * (q + 1) : r * (q + 1) + (xcd - r) * q) + off; }
        const int nig = WGM * nN, gid = wgid / nig, fm = gid * WGM, gsz = (nM - fm) < WGM ? (nM - fm) : WGM;
        u.pm = fm + ((wgid % nig) % gsz); u.pn = (wgid % nig) / gsz; return true;
    }
    __device__ __forceinline__ void a_ready(const Unit&) const {}
    __device__ __forceinline__ void done(const Unit&) const {}
};

__device__ __forceinline__ unsigned cvt_pk_bf16(float lo, float hi) { unsigned r; asm volatile("v_cvt_pk_bf16_f32 %0, %1, %2" : "=v"(r) : "v"(lo), "v"(hi)); return r; }
__device__ __forceinline__ float silu_f(float x) { return x * __builtin_amdgcn_rcpf(1.0f + __builtin_amdgcn_exp2f(-1.4426950408889634f * x)); }
struct EpiProj {
    static constexpr bool PERM = true, AFTER_DRAIN = false;
    bf16_t* O; int ldc;
    __device__ __forceinline__ void operator()(const f32x4 (&acc)[2][2][4][2], const Unit& u, int wr, int wc, int fr, int fq) const {
        const int row0 = u.pm * BM + wr * 64 + fr; const int col0 = u.pn * BM + wc * 32 + 8 * fq;
        const bool gate = (u.pn >= 12 && u.pn < 16) || u.pn == 22 || u.pn == 23 || u.pn >= 26;
#pragma unroll
        for (int ai = 0; ai < 2; ++ai)
#pragma unroll
            for (int m = 0; m < 4; ++m) { bf16_t* rowp = O + (size_t)(row0 + ai * HALF + m * 16) * ldc + col0;
#pragma unroll
                for (int bj = 0; bj < 2; ++bj) { f32x4 v0 = acc[ai][bj][m][0], v1 = acc[ai][bj][m][1];
                    if (gate) { v0 = (f32x4){silu_f(v0[0]), silu_f(v0[1]), silu_f(v0[2]), silu_f(v0[3])}; v1 = (f32x4){silu_f(v1[0]), silu_f(v1[1]), silu_f(v1[2]), silu_f(v1[3])}; }
                    u32x4 w; w.x = cvt_pk_bf16(v0[0], v0[1]); w.y = cvt_pk_bf16(v0[2], v0[3]); w.z = cvt_pk_bf16(v1[0], v1[1]); w.w = cvt_pk_bf16(v1[2], v1[3]);
                    *(u32x4*)(rowp + bj * HALF) = w; } }
    }
};
struct EpiRes {
    static constexpr bool PERM = false, AFTER_DRAIN = false;
    const float* base; float* out; int ldc; float alpha;
    __device__ __forceinline__ void operator()(const f32x4 (&acc)[2][2][4][2], const Unit& u, int wr, int wc, int fr, int fq) const {
        const int col0 = u.pn * BM + wc * 32 + 4 * fq;
#pragma unroll
        for (int ai = 0; ai < 2; ++ai)
#pragma unroll
            for (int m = 0; m < 4; ++m) { const size_t off = (size_t)(u.pm * BM + ai * HALF + wr * 64 + m * 16 + fr) * ldc + col0;
#pragma unroll
                for (int bj = 0; bj < 2; ++bj)
#pragma unroll
                    for (int n = 0; n < 2; ++n) { const f32x4 bs = *(const f32x4*)(base + off + bj * HALF + n * 16); *(f32x4*)(out + off + bj * HALF + n * 16) = bs * alpha + acc[ai][bj][m][n]; }
                asm volatile("" ::: "memory"); }
    }
};
template <class Epi, class Sched, bool ALIGN_EPI = false, bool SP2 = false>
__device__ __forceinline__ void gemm_phase(PG8_LAS unsigned char* lds, const Gemm g, const Sched& S, const Epi& E) {
    int tid = threadIdx.x; asm volatile("" : "+v"(tid));
    const int wid = __builtin_amdgcn_readfirstlane(tid >> 6), lane = tid & 63, wr = wid >> 2, wc = wid & 3, fr = lane & 15, fq = lane >> 4;
    const int K = g.K, nt = K / BK;
    unsigned voffA[2], voffB[2];
#pragma unroll
    for (int i = 0; i < 2; ++i) { int R, C; stage_rc(tid * 16 + i * 8192, R, C); const int Rb = Epi::PERM ? ((R & ~31) + perm32(R & 31)) : R;
        voffA[i] = (unsigned)(R * K + C) * 2u; voffB[i] = (unsigned)(Rb * K + C) * 2u; }
    const size_t kstep = (size_t)(BK * 2);
    const size_t hstep = (size_t)HALF * K * 2;
    const size_t tstep = 2 * hstep;
    const unsigned ldsw = (unsigned)wid * 1024u;
    const int aoff = lds_byte(wr * 64 + fr, fq * 8), boff = lds_byte(wc * 32 + fr, fq * 8);
#define PG8_SA(b, h) (((b) * 2 + (h)) * HTB)
#define PG8_SB(b, h) ((4 + (b) * 2 + (h)) * HTB)
#define PG8_STAGE(bufoff, gbase, voff) do { _Pragma("unroll") for (int _i = 0; _i < 2; ++_i) \
        __builtin_amdgcn_global_load_lds((const unsigned*)((const char*)(gbase) + (voff)[_i]), (PG8_LAS unsigned*)(lds + (bufoff) + ldsw + _i * 8192), 16, 0, 0); } while (0)
#define PG8_LDA(dst, b, h) do { _Pragma("unroll") for (int m = 0; m < 4; ++m) _Pragma("unroll") for (int k = 0; k < 2; ++k) dst[m][k] = *(const PG8_LAS bf16x8*)(lds + PG8_SA(b, h) + aoff + m * 2048 + k * 1024); } while (0)
#define PG8_LDB(dst, b, h) do { _Pragma("unroll") for (int n = 0; n < 2; ++n) _Pragma("unroll") for (int k = 0; k < 2; ++k) dst[n][k] = *(const PG8_LAS bf16x8*)(lds + PG8_SB(b, h) + boff + n * 2048 + k * 1024); } while (0)
#define PG8_MMA(ai, bj, At, Bt) do { __builtin_amdgcn_s_setprio(1); _Pragma("unroll") for (int m = 0; m < 4; ++m) _Pragma("unroll") for (int n = 0; n < 2; ++n) _Pragma("unroll") for (int k = 0; k < 2; ++k) \
        acc[ai][bj][m][n] = __builtin_amdgcn_mfma_f32_16x16x32_bf16(Bt[n][k], At[m][k], acc[ai][bj][m][n], 0, 0, 0); __builtin_amdgcn_s_setprio(0); } while (0)
#define PG8_WAIT_V(n) asm volatile("s_waitcnt vmcnt(" #n ")" ::: "memory")
#define PG8_WAIT_L(n) asm volatile("s_waitcnt lgkmcnt(" #n ")" ::: "memory")
#define PG8_BAR __builtin_amdgcn_s_barrier()
#define PG8_SCHED __builtin_amdgcn_sched_barrier(0)
    Unit cur, nxt; int ui = 0;
    if (!S.next(0, cur)) return;
    f32x4 acc[2][2][4][2];
#pragma unroll
    for (int a = 0; a < 2; ++a)
#pragma unroll
        for (int b = 0; b < 2; ++b)
#pragma unroll
            for (int m = 0; m < 4; ++m)
#pragma unroll
                for (int n = 0; n < 2; ++n) acc[a][b][m][n] = (f32x4){0.f, 0.f, 0.f, 0.f};
    bf16x8 At[4][2], B0[2][2], B1[2][2];
    const char* cA = (const char*)g.A + (size_t)cur.pm * tstep; const char* cB = (const char*)g.Bt + (size_t)cur.pn * tstep;
    S.a_ready(cur);
    if constexpr (SP2) {
        PG8_STAGE(PG8_SB(0, 0), cB, voffB); PG8_STAGE(PG8_SB(0, 1), cB + hstep, voffB); PG8_STAGE(PG8_SA(0, 0), cA, voffA); PG8_STAGE(PG8_SA(0, 1), cA + hstep, voffA);
        if (wr == 1) PG8_BAR;
        PG8_WAIT_V(2); PG8_BAR;
        PG8_STAGE(PG8_SB(1, 0), cB + kstep, voffB); PG8_STAGE(PG8_SA(1, 0), cA + kstep, voffA); PG8_STAGE(PG8_SB(1, 1), cB + hstep + kstep, voffB);
        PG8_WAIT_V(6); PG8_BAR;
    } else {
        PG8_STAGE(PG8_SB(0, 0), cB, voffB); PG8_STAGE(PG8_SA(0, 0), cA, voffA); PG8_STAGE(PG8_SB(0, 1), cB + hstep, voffB); PG8_STAGE(PG8_SA(0, 1), cA + hstep, voffA);
        if (wr == 1) PG8_BAR;
        PG8_WAIT_V(4); PG8_BAR;
        PG8_STAGE(PG8_SB(1, 0), cB + kstep, voffB); PG8_STAGE(PG8_SA(1, 0), cA + kstep, voffA); PG8_STAGE(PG8_SB(1, 1), cB + hstep + kstep, voffB);
        PG8_WAIT_V(6); PG8_BAR;
    }
    for (;;) {
        const bool has_next = S.next(ui + 1, nxt);
        const char* nA = has_next ? (const char*)g.A + (size_t)nxt.pm * tstep : cA; const char* nB = has_next ? (const char*)g.Bt + (size_t)nxt.pn * tstep : cB;
        for (int t = 0; t < nt; t += 2) {
            const bool last = (t == nt - 2);
            const char* a1 = cA + (size_t)(t + 1) * kstep;
            const char* a2 = last ? nA : cA + (size_t)(t + 2) * kstep; const char* b2 = last ? nB : cB + (size_t)(t + 2) * kstep;
            const char* a3 = a2 + kstep; const char* b3 = b2 + kstep;
            if (last && has_next) S.a_ready(nxt);
            if constexpr (SP2) {
            PG8_LDB(B0, 0, 0); PG8_LDB(B1, 0, 1); PG8_SCHED; PG8_LDA(At, 0, 0); PG8_STAGE(PG8_SA(1, 1), a1 + hstep, voffA);
            PG8_WAIT_V(8); PG8_WAIT_L(0); PG8_BAR; PG8_MMA(0, 0, At, B0); PG8_MMA(0, 1, At, B1); PG8_BAR; PG8_SCHED;
            PG8_LDA(At, 0, 1); PG8_STAGE(PG8_SB(0, 0), b2, voffB); PG8_STAGE(PG8_SB(0, 1), b2 + hstep, voffB); PG8_STAGE(PG8_SA(0, 0), a2, voffA);
            PG8_WAIT_V(8); PG8_WAIT_L(0); PG8_BAR; PG8_MMA(1, 0, At, B0); PG8_MMA(1, 1, At, B1); PG8_BAR; PG8_SCHED;
            PG8_LDB(B0, 1, 0); PG8_LDB(B1, 1, 1); PG8_SCHED; PG8_LDA(At, 1, 0); PG8_STAGE(PG8_SA(0, 1), a2 + hstep, voffA);
            PG8_WAIT_V(8); PG8_WAIT_L(0); PG8_BAR; PG8_MMA(0, 0, At, B0); PG8_MMA(0, 1, At, B1); PG8_BAR; PG8_SCHED;
            PG8_LDA(At, 1, 1); PG8_STAGE(PG8_SB(1, 0), b3, voffB); PG8_STAGE(PG8_SB(1, 1), b3 + hstep, voffB); PG8_STAGE(PG8_SA(1, 0), a3, voffA);
            PG8_WAIT_V(8); PG8_WAIT_L(0); PG8_BAR; PG8_MMA(1, 0, At, B0); PG8_MMA(1, 1, At, B1); PG8_BAR; PG8_SCHED;
            } else {
            PG8_LDB(B0, 0, 0); PG8_SCHED; PG8_LDA(At, 0, 0); PG8_STAGE(PG8_SA(1, 1), a1 + hstep, voffA);
            PG8_WAIT_L(8); PG8_BAR; PG8_WAIT_L(0); PG8_MMA(0, 0, At, B0); PG8_BAR; PG8_SCHED;
            PG8_LDB(B1, 0, 1); PG8_STAGE(PG8_SB(0, 0), b2, voffB);
            PG8_BAR; PG8_WAIT_L(0); PG8_MMA(0, 1, At, B1); PG8_BAR;
            PG8_LDA(At, 0, 1); PG8_STAGE(PG8_SA(0, 0), a2, voffA);
            PG8_BAR; PG8_WAIT_L(0); PG8_MMA(1, 0, At, B0); PG8_BAR; PG8_SCHED;
            PG8_STAGE(PG8_SB(0, 1), b2 + hstep, voffB);
            PG8_WAIT_V(6); PG8_BAR; PG8_MMA(1, 1, At, B1); PG8_BAR;
            PG8_LDB(B0, 1, 0); PG8_SCHED; PG8_LDA(At, 1, 0); PG8_STAGE(PG8_SA(0, 1), a2 + hstep, voffA);
            PG8_WAIT_L(8); PG8_BAR; PG8_WAIT_L(0); PG8_MMA(0, 0, At, B0); PG8_BAR; PG8_SCHED;
            PG8_LDB(B1, 1, 1); PG8_STAGE(PG8_SB(1, 0), b3, voffB);
            PG8_BAR; PG8_WAIT_L(0); PG8_MMA(0, 1, At, B1); PG8_BAR;
            PG8_LDA(At, 1, 1); PG8_STAGE(PG8_SA(1, 0), a3, voffA);
            PG8_BAR; PG8_WAIT_L(0); PG8_MMA(1, 0, At, B0); PG8_BAR; PG8_SCHED;
            PG8_STAGE(PG8_SB(1, 1), b3 + hstep, voffB);
            PG8_WAIT_V(6); PG8_BAR; PG8_MMA(1, 1, At, B1); PG8_BAR;
            }
        }
        if constexpr (ALIGN_EPI) { if (wr == 0) PG8_BAR; }
        if constexpr (!Epi::AFTER_DRAIN) { E(acc, cur, wr, wc, fr, fq); S.done(cur); }
        if (!has_next) break;
#pragma unroll
        for (int a = 0; a < 2; ++a)
#pragma unroll
            for (int b = 0; b < 2; ++b)
#pragma unroll
                for (int m = 0; m < 4; ++m)
#pragma unroll
                    for (int n = 0; n < 2; ++n) acc[a][b][m][n] = (f32x4){0.f, 0.f, 0.f, 0.f};
        cur = nxt; cA = nA; cB = nB; ++ui;
        if constexpr (ALIGN_EPI) { if (wr == 1) PG8_BAR; }
    }
    PG8_WAIT_V(0);
    if constexpr (!ALIGN_EPI) { if (wr == 0) PG8_BAR; }
    PG8_BAR;
    if constexpr (Epi::AFTER_DRAIN) { E.fused(acc, cur, wr, wc, fr, fq, lds, wid, lane); S.done(cur); }
#undef PG8_SA
#undef PG8_SB
#undef PG8_STAGE
#undef PG8_LDA
#undef PG8_LDB
#undef PG8_MMA
#undef PG8_WAIT_V
#undef PG8_WAIT_L
#undef PG8_BAR
#undef PG8_SCHED
}
}

namespace att {
constexpr int D = 128, NW = 8, QBLK = 32, KVBLK = 64, QB = NW * QBLK;
constexpr int SHM_V = KVBLK * D * 2, SHM_K = KVBLK * D * 2;
constexpr int LDP = 7168, LDO = 2048;
constexpr float SCALE = 0.08838834764831845f; constexpr float THR = 8.f; constexpr bool WSKIP = false;
constexpr int KB_OFF = 2 * SHM_V + 2 * SHM_K + NW * 64 * 4;
constexpr int SCAN_OFF = KB_OFF + 4096 * 4;
constexpr int OST_OFF = SCAN_OFF + 64;
constexpr int ATT_LDS = OST_OFF + NW * QBLK * D * 2;
using bf16 = __hip_bfloat16;
typedef short bf16x8 __attribute__((ext_vector_type(8)));
typedef short s16x4 __attribute__((ext_vector_type(4)));
typedef float f32x16 __attribute__((ext_vector_type(16)));
typedef float f32x4 __attribute__((ext_vector_type(4)));
typedef unsigned u32x4 __attribute__((ext_vector_type(4)));
template <class A, class Bt> struct same_t { static constexpr bool v = false; };
template <class A> struct same_t<A, A> { static constexpr bool v = true; };
#define KSWZ(row, colB) ((row) * 256 + ((colB) ^ (((row) & 7) << 4)))
#define SBAR() __builtin_amdgcn_sched_barrier(0)
__device__ __forceinline__ int v_st(int k, int c) { const int kk = (k & ~0xC) | ((k & 4) << 1) | ((k & 8) >> 1); return ((kk >> 3) * 4 + (c >> 5)) * 512 + ((kk & 7) * 32 + (c & 31)) * 2; }
__device__ __forceinline__ int v_rd_base(int lane) { return ((lane & 3) << 3) | (((lane >> 2) & 3) << 6) | (((lane >> 4) & 1) << 5) | (((lane >> 5) & 1) << 8); }
constexpr int v_rd_off(int d0, int ks, int half) { return d0 * 512 + ks * 4096 + half * 2048; }
__device__ __forceinline__ int crow(int r, int hi) { return (r & 3) + 8 * (r >> 2) + 4 * hi; }
__device__ __forceinline__ unsigned cvtpk(float lo, float hi) {
    unsigned r; asm volatile("v_cvt_pk_bf16_f32 %0, %1, %2" : "=v"(r) : "v"(lo), "v"(hi)); return r;
}
__device__ __forceinline__ bf16x8 pack8(f32x4 a, f32x4 b) {
    u32x4 w = {cvtpk(a[0], a[1]), cvtpk(a[2], a[3]), cvtpk(b[0], b[1]), cvtpk(b[2], b[3])};
    return *reinterpret_cast<bf16x8*>(&w);
}
template <class T> __device__ __forceinline__ bf16x8 load8(const T* p) {
    if constexpr (same_t<T, float>::v) { return pack8(*(const f32x4*)p, *(const f32x4*)(p + 4)); }
    else { return *reinterpret_cast<const bf16x8*>(p); }
}
__device__ __forceinline__ void mask_tile(f32x16& p0, f32x16& p1, int dq, unsigned W) {
    const float NEG = -__builtin_inff();
#pragma unroll
    for (int r = 0; r < 16; ++r) {
        const int c = (r & 3) + 8 * (r >> 2);
        if ((unsigned)(dq - c) >= W) p0[r] = NEG;
        if ((unsigned)(dq - c - 32) >= W) p1[r] = NEG;
    }
}
__device__ __forceinline__ void partialSM(f32x16& p0, f32x16& p1, float& m_reg, float& mn, float& alpha) {
    float pmax = p0[0]; for (int r = 1; r < 16; ++r) pmax = fmaxf(pmax, p0[r]); for (int r = 0; r < 16; ++r) pmax = fmaxf(pmax, p1[r]);
    { auto rr = __builtin_amdgcn_permlane32_swap(__float_as_uint(pmax), __float_as_uint(pmax), false, false);
      pmax = fmaxf(__uint_as_float(rr[0]), __uint_as_float(rr[1])); }
    constexpr float C2 = 1.4426950408889634f * SCALE;
    if (__builtin_expect(__all((pmax - m_reg) * SCALE <= THR), 1)) { mn = m_reg; alpha = 1.f; }
    else { mn = fmaxf(m_reg, pmax); alpha = __builtin_amdgcn_exp2f((m_reg - mn) * C2); m_reg = mn; }
    const float mnL = -mn * C2;
    for (int r = 0; r < 16; ++r) p0[r] = fmaf(p0[r], C2, mnL); for (int r = 0; r < 16; ++r) p1[r] = fmaf(p1[r], C2, mnL);
    for (int r = 0; r < 16; ++r) p0[r] = __builtin_amdgcn_exp2f(p0[r]);
}
__device__ __forceinline__ void finishSM(f32x16& p0, f32x16& p1, float alpha, float& l_reg, bf16x8& pa0, bf16x8& pa1, bf16x8& pa2, bf16x8& pa3) {
    for (int r = 0; r < 16; ++r) p1[r] = __builtin_amdgcn_exp2f(p1[r]);
    float ps = 0; for (int r = 0; r < 16; ++r) ps += p0[r]; for (int r = 0; r < 16; ++r) ps += p1[r];
    { auto rr = __builtin_amdgcn_permlane32_swap(__float_as_uint(ps), __float_as_uint(ps), false, false);
      ps = __uint_as_float(rr[0]) + __uint_as_float(rr[1]); }
    l_reg = l_reg * alpha + ps;
#define PK4(P, B_, OUT) do { unsigned a0 = cvtpk(P[B_+0], P[B_+1]), a1 = cvtpk(P[B_+2], P[B_+3]);                          \
        unsigned b0 = cvtpk(P[B_+4], P[B_+5]), b1 = cvtpk(P[B_+6], P[B_+7]);                                             \
        auto r0 = __builtin_amdgcn_permlane32_swap(a0, b0, false, false); auto r1 = __builtin_amdgcn_permlane32_swap(a1, b1, false, false); \
        u32x4 w = {r0[0], r1[0], r0[1], r1[1]}; OUT = *reinterpret_cast<bf16x8*>(&w); } while (0)
    PK4(p0, 0, pa0); PK4(p0, 8, pa1); PK4(p1, 0, pa2); PK4(p1, 8, pa3);
#undef PK4
}
template <int KB, bool SK>
__device__ __forceinline__ void qkt(f32x16& p0, f32x16& p1, const char* K_lds, int r32, int hi, const bf16x8* qr, bool act) {
    if (SK && !act) { const float NEG = -__builtin_inff();
#pragma unroll
        for (int r = 0; r < 16; ++r) { p0[r] = NEG; p1[r] = NEG; } return; }
    p0 = f32x16{}; p1 = f32x16{};
    const char* kb[4];
#pragma unroll
    for (int dd = 0; dd < 4; ++dd) kb[dd] = K_lds + KB * SHM_K + KSWZ(r32, (dd * 16 + hi * 8) * 2);
#pragma unroll
    for (int d0 = 0; d0 < 8; ++d0) { const char* a = kb[d0 & 3] + (d0 >> 2) * 128;
        bf16x8 b0 = *reinterpret_cast<const bf16x8*>(a);
        bf16x8 b1 = *reinterpret_cast<const bf16x8*>(a + 32 * 256);
        p0 = __builtin_amdgcn_mfma_f32_32x32x16_bf16(b0, qr[d0], p0, 0, 0, 0);
        p1 = __builtin_amdgcn_mfma_f32_32x32x16_bf16(b1, qr[d0], p1, 0, 0, 0); }
}
template <int VB, bool SK>
__device__ __forceinline__ void pv_tile(f32x16* o, int vb0, bf16x8 pa0, bf16x8 pa1, bf16x8 pa2, bf16x8 pa3, bool act) {
    if (SK && !act) return;
#define TRRD(dst, off) asm volatile("ds_read_b64_tr_b16 %0, %1 offset:%2" : "=&v"(dst) : "v"(vb0), "i"(off) : "memory")
#define PV_D0(d0) do { s16x4 l0, l1, l2, l3, h0, h1, h2, h3; constexpr int b_ = VB * SHM_V + v_rd_off(d0, 0, 0);     \
        TRRD(l0, b_); TRRD(h0, b_ + 2048); TRRD(l1, b_ + 4096); TRRD(h1, b_ + 6144); TRRD(l2, b_ + 8192); TRRD(h2, b_ + 10240); TRRD(l3, b_ + 12288); TRRD(h3, b_ + 14336); \
        asm volatile("s_waitcnt lgkmcnt(0)" ::: "memory"); SBAR();                 \
        o[d0] = __builtin_amdgcn_mfma_f32_32x32x16_bf16(pa0, (bf16x8){l0[0], l0[1], l0[2], l0[3], h0[0], h0[1], h0[2], h0[3]}, o[d0], 0, 0, 0);   \
        o[d0] = __builtin_amdgcn_mfma_f32_32x32x16_bf16(pa1, (bf16x8){l1[0], l1[1], l1[2], l1[3], h1[0], h1[1], h1[2], h1[3]}, o[d0], 0, 0, 0);   \
        o[d0] = __builtin_amdgcn_mfma_f32_32x32x16_bf16(pa2, (bf16x8){l2[0], l2[1], l2[2], l2[3], h2[0], h2[1], h2[2], h2[3]}, o[d0], 0, 0, 0);   \
        o[d0] = __builtin_amdgcn_mfma_f32_32x32x16_bf16(pa3, (bf16x8){l3[0], l3[1], l3[2], l3[3], h3[0], h3[1], h3[2], h3[3]}, o[d0], 0, 0, 0); } while (0)
    PV_D0(0); PV_D0(1); PV_D0(2); PV_D0(3);
#undef PV_D0
#undef TRRD
}
template <class TIn>
__device__ __forceinline__ void fox_block(const TIn* Qp, const TIn* Kp, const TIn* Vp, const TIn* Gp, TIn* Op, int P0, char* lds) {
    int tid = threadIdx.x; asm volatile("" : "+v"(tid));
    const int wid = __builtin_amdgcn_readfirstlane(tid >> 6), lane = tid & 63, r32 = lane & 31, hi = lane >> 5;
    const int NT = (P0 + QB) / KVBLK;
    const int qlo = P0 + wid * QBLK, qm = qlo + r32 - 4 * hi;
    char* V_lds = lds; char* K_lds = lds + 2 * SHM_V;
    float* ws = (float*)(lds + 2 * SHM_V + 2 * SHM_K) + wid * 64; float* li_l = ws, * al_l = ws + 32;
    const float* kbl = (const float*)(lds + KB_OFF) + 4 * hi;
    const int sr = tid >> 4, sc = (tid & 15) * 8, vst0 = v_st(sr, sc), vst1 = v_st(32 + sr, sc), kws = KSWZ(sr, sc * 2);
    const unsigned vo0 = (unsigned)(sr * LDP + sc) * 2u, vo1 = vo0 + 32u * LDP * 2u;
    const int vb0 = (int)(uintptr_t)V_lds + v_rd_base(lane);
    bf16x8 qr[8];
    { const char* qb_ = (const char*)(Qp + (size_t)(wid * QBLK) * LDP) + (unsigned)(r32 * LDP + hi * 8) * 2u;
#pragma unroll
      for (int d0 = 0; d0 < 8; ++d0) qr[d0] = *(const bf16x8*)(qb_ + d0 * 32); }
    bf16x8 s0, s1;
#define LD2(p, t) do { const char* b_ = (const char*)((p) + (size_t)(t) * KVBLK * LDP); s0 = *(const bf16x8*)(b_ + vo0); s1 = *(const bf16x8*)(b_ + vo1); } while (0)
#define WRK(bf) do { *(bf16x8*)(K_lds + (bf) * SHM_K + kws) = s0; *(bf16x8*)(K_lds + (bf) * SHM_K + kws + 32 * 256) = s1; } while (0)
#define WRV(bf) do { *(bf16x8*)(V_lds + (bf) * SHM_V + vst0) = s0; *(bf16x8*)(V_lds + (bf) * SHM_V + vst1) = s1; } while (0)
#define KBASE(t) ((t) * KVBLK)
#define ADDB(P0_, P1_, t) do { const f32x4* kb4_ = (const f32x4*)(kbl + KBASE(t)); _Pragma("unroll") for (int g_ = 0; g_ < 4; ++g_) { const f32x4 a_ = kb4_[2 * g_], b_ = kb4_[8 + 2 * g_]; \
        _Pragma("unroll") for (int e_ = 0; e_ < 4; ++e_) { P0_[4 * g_ + e_] += a_[e_]; P1_[4 * g_ + e_] += b_[e_]; } } } while (0)
#define RESC(a) do { if (__any((a) < 1.f)) { if (hi == 0) al_l[r32] = (a); asm volatile("s_waitcnt lgkmcnt(0)" ::: "memory");              \
                     for (int d_ = 0; d_ < 4; ++d_) for (int r = 0; r < 16; ++r) o[d_][r] *= al_l[crow(r, hi)]; } } while (0)
    LD2(Kp, 0); WRK(0); LD2(Vp, 0); WRV(0);
    __syncthreads();
    float m_reg = -1e30f, l_reg = 0; f32x16 o[4] = {};
#define STEP(t, B_, NB_) do { const bool more_ = (t) + 1 < NT;                                                                \
        if (more_) LD2(Kp, (t) + 1);                                                                                          \
        f32x16 p0, p1; SBAR(); qkt<B_, false>(p0, p1, K_lds, r32, hi, qr, true); SBAR();                                      \
        if (more_) { WRK(NB_); LD2(Vp, (t) + 1); }                                                                            \
        ADDB(p0, p1, (t));                                                                                                    \
        if (KBASE(t) + KVBLK - 1 > qlo) mask_tile(p0, p1, qm - KBASE(t), 1u << 30);                                           \
        float mn_, al_; partialSM(p0, p1, m_reg, mn_, al_); RESC(al_);                                                        \
        bf16x8 pa0, pa1, pa2, pa3; finishSM(p0, p1, al_, l_reg, pa0, pa1, pa2, pa3); SBAR();                                  \
        pv_tile<B_, false>(o, vb0, pa0, pa1, pa2, pa3, true);                                                                 \
        if (more_) WRV(NB_);                                                                                                  \
        __syncthreads(); } while (0)
#pragma unroll 1
    for (int t = 0; t < NT; t += 2) { STEP(t, 0, 1); STEP(t + 1, 1, 0); }
    if (hi == 0) li_l[r32] = l_reg; asm volatile("s_waitcnt lgkmcnt(0)" ::: "memory");
    float rli[16];
#pragma unroll
    for (int r = 0; r < 16; ++r) rli[r] = __builtin_amdgcn_rcpf(li_l[crow(r, hi)]);
    {
        unsigned short* stg = (unsigned short*)(lds + OST_OFF) + wid * (QBLK * D);
#pragma unroll
        for (int r = 0; r < 16; ++r) { const int orow = crow(r, hi);
#pragma unroll
            for (int d0 = 0; d0 < 4; ++d0) { const float v = o[d0][r] * rli[r]; stg[orow * D + d0 * 32 + r32] = (unsigned short)(cvtpk(v, 0.f) & 0xffffu); } }
        asm volatile("s_waitcnt lgkmcnt(0)" ::: "memory");
        const unsigned go = (unsigned)((lane >> 4) * LDP + (lane & 15) * 8) * 2u, oo = (unsigned)((lane >> 4) * LDO + (lane & 15) * 8) * 2u, so = (unsigned)((lane >> 4) * D + (lane & 15) * 8);
#pragma unroll
        for (int i = 0; i < 8; ++i) {
            const u32x4 ov = *(const u32x4*)(stg + i * 4 * D + so);
            const u32x4 gv = *(const u32x4*)((const char*)(Gp + (size_t)(wid * QBLK + i * 4) * LDP) + go);
            u32x4 w;
#pragma unroll
            for (int e = 0; e < 4; ++e) w[e] = cvtpk(__uint_as_float(ov[e] << 16) * __uint_as_float(gv[e] << 16), __uint_as_float(ov[e] & 0xffff0000u) * __uint_as_float(gv[e] & 0xffff0000u));
            *(u32x4*)((char*)(Op + (size_t)(wid * QBLK + i * 4) * LDO) + oo) = w;
            if (i & 1) asm volatile("" ::: "memory"); }
    }
    __syncthreads();
#undef LD2
#undef WRK
#undef WRV
#undef KBASE
#undef ADDB
#undef RESC
#undef STEP
}
}

constexpr int DM = 2048, NBATCH = 8, SEQ = 4096, DEPTH = 4, MTOK = NBATCH * SEQ, NHEAD = 8;
constexpr int INW = 7176, PJ = 7168;
constexpr int C_Q = 0, C_K = 1024, C_V = 2048, C_GA = 3072, C_CB = 4096, C_CC = 4608, C_CH = 5120, C_GC = 5632, C_PU = 6144, C_GP = 6656;
constexpr int Y_ATT = 0, Y_CONV = 1024, Y_POOL = 1536;
constexpr float LN_EPS = 1e-5f;
constexpr float ALPHA = 1.6817928305074290f;
constexpr size_t MiB = 1u << 20;
constexpr size_t WS_WIN = 0, WS_WOUT = 112 * MiB, WS_WFG = 144 * MiB, WS_PWT = 145 * MiB, WS_LF = 146 * MiB, WS_XN = 148 * MiB, WS_PROJ = 276 * MiB, WS_Y = 724 * MiB, WS_END = 852 * MiB;
constexpr int LDS_BYTES = 155648;
static_assert(att::ATT_LDS <= LDS_BYTES, "LDS map");
constexpr int NWAVES = 8;

typedef unsigned short bf16u;
typedef float f32x4 __attribute__((ext_vector_type(4)));
typedef unsigned u32x4 __attribute__((ext_vector_type(4)));
typedef unsigned u32x2 __attribute__((ext_vector_type(2)));
typedef short bf16x8 __attribute__((ext_vector_type(8)));
#define LAS __attribute__((address_space(3)))
__device__ __forceinline__ unsigned pk2(float lo, float hi) { unsigned r; asm volatile("v_cvt_pk_bf16_f32 %0, %1, %2" : "=v"(r) : "v"(lo), "v"(hi)); return r; }
__device__ __forceinline__ float bflo(unsigned w) { return __uint_as_float(w << 16); }
__device__ __forceinline__ float bfhi(unsigned w) { return __uint_as_float(w & 0xffff0000u); }
__device__ __forceinline__ float wave_sum(float v) {
#pragma unroll
    for (int o = 1; o < 64; o <<= 1) v += __shfl_xor(v, o);
    return v;
}

struct Args { const float* x; const float* w_in; const float* b_f; const float* conv_w; const float* pool_w; const float* pool_scale; const float* w_out; const float* ln_g; const float* ln_b;
              float* out; unsigned char* ws; int ph_lo, ph_hi; };

__device__ __forceinline__ void transpose_item(const float* W, int ldw, int K, int src_n0, bf16u* WT, int dst_n0, int k0, LAS float* scr, int lane) {
#pragma unroll 8
    for (int i = 0; i < 32; ++i) { const int kk = 2 * i + (lane >> 5); scr[kk * 33 + (lane & 31)] = W[(size_t)(k0 + kk) * ldw + src_n0 + (lane & 31)]; }
    asm volatile("s_waitcnt lgkmcnt(0)" ::: "memory");
    const int c = lane & 7;
#pragma unroll
    for (int j = 0; j < 4; ++j) { const int n = (lane >> 3) + 8 * j; const LAS float* s = scr + (8 * c) * 33 + n;
        u32x4 o; o.x = pk2(s[0 * 33], s[1 * 33]); o.y = pk2(s[2 * 33], s[3 * 33]); o.z = pk2(s[4 * 33], s[5 * 33]); o.w = pk2(s[6 * 33], s[7 * 33]);
        *(u32x4*)(WT + (size_t)(dst_n0 + n) * K + k0 + 8 * c) = o; }
    asm volatile("s_waitcnt lgkmcnt(0)" ::: "memory");
}
__device__ __forceinline__ void prologue_phase(const Args& a, LAS unsigned char* lds, int gw, int NGW, int wave, int lane) {
    LAS float* scr = (LAS float*)(lds + wave * 16384);
    bf16u* WinT = (bf16u*)(a.ws + WS_WIN); bf16u* WoutT = (bf16u*)(a.ws + WS_WOUT); bf16u* Wfg = (bf16u*)(a.ws + WS_WFG); bf16u* PWt = (bf16u*)(a.ws + WS_PWT); bf16u* XN = (bf16u*)(a.ws + WS_XN);
    constexpr int I_IN = (DM / 64) * (PJ / 32), I_OUT = (DM / 64) * (DM / 32);
    for (int it = gw; it < DEPTH * (I_IN + I_OUT); it += NGW) {
        const int l = it / (I_IN + I_OUT); int r = it % (I_IN + I_OUT);
        if (r < I_IN) { const int nblk = PJ / 32, kb = r / nblk, nb = r % nblk, n0 = 32 * nb;
            transpose_item(a.w_in + (size_t)l * DM * INW, INW, DM, n0 + (n0 >= 4096 ? 8 : 0), WinT + (size_t)l * PJ * DM, n0, 64 * kb, scr, lane); }
        else { r -= I_IN; const int nblk = DM / 32, kb = r / nblk, nb = r % nblk;
            transpose_item(a.w_out + (size_t)l * DM * DM, DM, DM, 32 * nb, WoutT + (size_t)l * DM * DM, 32 * nb, 64 * kb, scr, lane); }
    }
    const int gt = gw * 64 + lane, NGT = NGW * 64;
    for (int e = gt; e < DEPTH * 8 * DM; e += NGT) { const int l = e / (8 * DM), n = (e / DM) & 7, k = e % DM;
        const float v = a.w_in[(size_t)l * DM * INW + (size_t)k * INW + 4096 + n]; Wfg[e] = (bf16u)(pk2(v, 0.f) & 0xffffu); }
    for (int e = gt; e < DEPTH * 4 * 128 * 128; e += NGT) { const int lg = e >> 14, d = (e >> 7) & 127, c = e & 127;
        const float v = a.pool_w[(size_t)lg * 16384 + c * 128 + d]; PWt[e] = (bf16u)(pk2(v, 0.f) & 0xffffu); }
    for (size_t e = (size_t)gt; e < (size_t)MTOK * DM / 8; e += NGT) { const f32x4 v0 = ((const f32x4*)a.x)[2 * e], v1 = ((const f32x4*)a.x)[2 * e + 1];
        u32x4 o; o.x = pk2(v0[0], v0[1]); o.y = pk2(v0[2], v0[3]); o.z = pk2(v1[0], v1[1]); o.w = pk2(v1[2], v1[3]); ((u32x4*)XN)[e] = o; }
}

__device__ __forceinline__ void fg_phase(const bf16u* XN, const bf16u* Wfg, const float* bf, float* LF, int gw, int NGW, int lane) {
    typedef float f4 __attribute__((ext_vector_type(4)));
    const int fr = lane & 15, fq = lane >> 4;
    for (int t = gw; t < MTOK / 16; t += NGW) {
        const bf16u* xr = XN + (size_t)(t * 16 + fr) * DM + fq * 32; const bf16u* wr_ = Wfg + (size_t)(fr & 7) * DM + fq * 32;
        f4 acc = {0.f, 0.f, 0.f, 0.f};
#pragma unroll 2
        for (int kc = 0; kc < DM; kc += 128) {
            bf16x8 xa[4], wb[4];
#pragma unroll
            for (int j = 0; j < 4; ++j) { xa[j] = *(const bf16x8*)(xr + kc + j * 8); wb[j] = *(const bf16x8*)(wr_ + kc + j * 8); }
#pragma unroll
            for (int j = 0; j < 4; ++j) acc = __builtin_amdgcn_mfma_f32_16x16x32_bf16(wb[j], xa[j], acc, 0, 0, 0);
        }
        if (fq < 2) { const int tok = t * 16 + fr, b = tok / SEQ, s = tok % SEQ;
#pragma unroll
            for (int e = 0; e < 4; ++e) { const int h = 4 * fq + e; const float z = acc[e] + bf[h];
                const float lf = fminf(z, 0.f) - log1pf(__expf(-fabsf(z)));
                LF[(size_t)(b * NHEAD + h) * SEQ + s] = lf; } }
    }
}

__device__ __forceinline__ void conv_phase(const bf16u* P, const float* cw, bf16u* Y, int gw, int NGW, int lane) {
    const int c0 = lane * 8;
    float w0[8], w1[8], w2[8];
#pragma unroll
    for (int j = 0; j < 8; ++j) { w0[j] = cw[c0 + j]; w1[j] = cw[512 + c0 + j]; w2[j] = cw[1024 + c0 + j]; }
    for (int t = gw; t < MTOK / 16; t += NGW) {
        const int tok0 = t * 16; const bool first = (tok0 % SEQ) == 0;
        float u1[8], u2[8];
#pragma unroll
        for (int j = 0; j < 8; ++j) { u1[j] = 0.f; u2[j] = 0.f; }
        if (!first) {
            const u32x4 c1 = *(const u32x4*)(P + (size_t)(tok0 - 1) * PJ + C_CC + c0), h1 = *(const u32x4*)(P + (size_t)(tok0 - 1) * PJ + C_CH + c0);
            const u32x4 c2 = *(const u32x4*)(P + (size_t)(tok0 - 2) * PJ + C_CC + c0), h2 = *(const u32x4*)(P + (size_t)(tok0 - 2) * PJ + C_CH + c0);
#pragma unroll
            for (int j = 0; j < 4; ++j) { u1[2 * j] = bflo(c1[j]) * bflo(h1[j]); u1[2 * j + 1] = bfhi(c1[j]) * bfhi(h1[j]); u2[2 * j] = bflo(c2[j]) * bflo(h2[j]); u2[2 * j + 1] = bfhi(c2[j]) * bfhi(h2[j]); }
        }
#pragma unroll 4
        for (int i = 0; i < 16; ++i) {
            const bf16u* row = P + (size_t)(tok0 + i) * PJ + c0;
            const u32x4 cc = *(const u32x4*)(row + C_CC), hh = *(const u32x4*)(row + C_CH), bb = *(const u32x4*)(row + C_CB), gg = *(const u32x4*)(row + C_GC);
            float u0[8], y[8];
#pragma unroll
            for (int j = 0; j < 4; ++j) { u0[2 * j] = bflo(cc[j]) * bflo(hh[j]); u0[2 * j + 1] = bfhi(cc[j]) * bfhi(hh[j]); }
#pragma unroll
            for (int j = 0; j < 4; ++j) {
                y[2 * j]     = bflo(bb[j]) * (w0[2 * j] * u2[2 * j] + w1[2 * j] * u1[2 * j] + w2[2 * j] * u0[2 * j]) * bflo(gg[j]);
                y[2 * j + 1] = bfhi(bb[j]) * (w0[2 * j + 1] * u2[2 * j + 1] + w1[2 * j + 1] * u1[2 * j + 1] + w2[2 * j + 1] * u0[2 * j + 1]) * bfhi(gg[j]); }
            u32x4 o; o.x = pk2(y[0], y[1]); o.y = pk2(y[2], y[3]); o.z = pk2(y[4], y[5]); o.w = pk2(y[6], y[7]);
            *(u32x4*)(Y + (size_t)(tok0 + i) * DM + Y_CONV + c0) = o;
#pragma unroll
            for (int j = 0; j < 8; ++j) { u2[j] = u1[j]; u1[j] = u0[j]; }
        }
    }
}

template <int G, int WIN>
__device__ __forceinline__ void pool_group(const bf16u* P, const bf16u* PWt, const float* ps, bf16u* Y, int tok0, int lane) {
    typedef float f4 __attribute__((ext_vector_type(4)));
    const int fr = lane & 15, fq = lane >> 4, tok = tok0 + fr, s = tok % SEQ;
    const int cnt = (s + 1 < WIN) ? s + 1 : WIN; const float rc = 1.0f / (float)cnt;
    f4 acc[8];
#pragma unroll
    for (int nb = 0; nb < 8; ++nb) acc[nb] = (f4){0.f, 0.f, 0.f, 0.f};
#pragma unroll 1
    for (int ks = 0; ks < 4; ++ks) {
        const bf16u* up = P + (size_t)tok * PJ + C_PU + G * 128 + ks * 32 + fq * 8;
        float sum[8], cur[8];
        { const u32x4 v = *(const u32x4*)up;
#pragma unroll
          for (int j = 0; j < 4; ++j) { cur[2 * j] = bflo(v[j]); cur[2 * j + 1] = bfhi(v[j]); sum[2 * j] = cur[2 * j]; sum[2 * j + 1] = cur[2 * j + 1]; } }
#pragma unroll
        for (int i = 1; i < WIN; ++i) { if (i < cnt) { const u32x4 v = *(const u32x4*)(up - (size_t)i * PJ);
#pragma unroll
            for (int j = 0; j < 4; ++j) { sum[2 * j] += bflo(v[j]); sum[2 * j + 1] += bfhi(v[j]); } }
            if ((i & 3) == 3) asm volatile("" ::: "memory"); }
        u32x4 zw;
        zw.x = pk2(sum[0] * rc - cur[0], sum[1] * rc - cur[1]); zw.y = pk2(sum[2] * rc - cur[2], sum[3] * rc - cur[3]);
        zw.z = pk2(sum[4] * rc - cur[4], sum[5] * rc - cur[5]); zw.w = pk2(sum[6] * rc - cur[6], sum[7] * rc - cur[7]);
        const bf16x8 zf = __builtin_bit_cast(bf16x8, zw);
#pragma unroll
        for (int nb = 0; nb < 8; ++nb) { const bf16x8 wf = *(const bf16x8*)(PWt + (size_t)(G * 128 + nb * 16 + fr) * 128 + ks * 32 + fq * 8);
            acc[nb] = __builtin_amdgcn_mfma_f32_16x16x32_bf16(wf, zf, acc[nb], 0, 0, 0); }
    }
#pragma unroll
    for (int nb = 0; nb < 8; ++nb) { const int col = G * 128 + nb * 16 + 4 * fq;
        const f32x4 sc = *(const f32x4*)(ps + col); const u32x2 gg = *(const u32x2*)(P + (size_t)tok * PJ + C_GP + col);
        u32x2 o; o.x = pk2(acc[nb][0] * sc[0] * bflo(gg.x), acc[nb][1] * sc[1] * bfhi(gg.x)); o.y = pk2(acc[nb][2] * sc[2] * bflo(gg.y), acc[nb][3] * sc[3] * bfhi(gg.y));
        *(u32x2*)(Y + (size_t)tok * DM + Y_POOL + col) = o; }
}
__device__ __forceinline__ void pool_phase(const bf16u* P, const bf16u* PWt, const float* ps, bf16u* Y, int gw, int NGW, int lane) {
    for (int t = gw; t < MTOK / 16; t += NGW) {
        pool_group<0, 2>(P, PWt, ps, Y, t * 16, lane); pool_group<1, 4>(P, PWt, ps, Y, t * 16, lane);
        pool_group<2, 8>(P, PWt, ps, Y, t * 16, lane); pool_group<3, 16>(P, PWt, ps, Y, t * 16, lane);
    }
}

__device__ __forceinline__ void ln_phase(float* X, const float* g, const float* bta, bf16u* XN, int gw, int NGW, int lane) {
    for (int m = gw; m < MTOK; m += NGW) {
        f32x4* xr = (f32x4*)(X + (size_t)m * DM) + lane;
        f32x4 v[8]; float s = 0.f;
#pragma unroll
        for (int j = 0; j < 8; ++j) { v[j] = xr[64 * j]; s += (v[j][0] + v[j][1]) + (v[j][2] + v[j][3]); }
        const float mean = wave_sum(s) * (1.f / DM); float s2 = 0.f;
#pragma unroll
        for (int j = 0; j < 8; ++j) { v[j] = v[j] - mean; s2 += (v[j][0] * v[j][0] + v[j][1] * v[j][1]) + (v[j][2] * v[j][2] + v[j][3] * v[j][3]); }
        const float rstd = 1.f / sqrtf(wave_sum(s2) * (1.f / DM) + LN_EPS);
        u32x2* o8 = (u32x2*)(XN + (size_t)m * DM) + lane;
#pragma unroll
        for (int j = 0; j < 8; ++j) { const f32x4 gg = ((const f32x4*)g)[64 * j + lane], bb = ((const f32x4*)bta)[64 * j + lane];
            const f32x4 o = v[j] * rstd * gg + bb; xr[64 * j] = o;
            u32x2 w; w.x = pk2(o[0], o[1]); w.y = pk2(o[2], o[3]); o8[64 * j] = w; }
    }
}

__device__ __forceinline__ void attn_phase(char* lds, const bf16u* P, bf16u* Y, const float* LF, int vcu) {
    using namespace att;
    int tid = threadIdx.x; asm volatile("" : "+v"(tid));
    const int lane = tid & 63, wid = tid >> 6;
    const int bh = vcu >> 2, s4 = vcu & 3, b = bh >> 3, h = bh & 7;
    {
        const float* lf = LF + (size_t)bh * SEQ + 8 * tid;
        const f32x4 a = *(const f32x4*)lf, c = *(const f32x4*)(lf + 4);
        float v0 = a[0], v1 = v0 + a[1], v2 = v1 + a[2], v3 = v2 + a[3], v4 = v3 + c[0], v5 = v4 + c[1], v6 = v5 + c[2], v7 = v6 + c[3];
        float incl = v7;
#pragma unroll
        for (int o = 1; o < 64; o <<= 1) { const float t = __shfl_up(incl, o); if (lane >= o) incl += t; }
        float* sc = (float*)(lds + SCAN_OFF);
        if (lane == 63) sc[wid] = incl;
        __syncthreads();
        float woff = 0.f;
#pragma unroll
        for (int w = 0; w < 8; ++w) if (w < wid) woff += sc[w];
        const float ex = woff + incl - v7; const float ns = -1.0f / SCALE;
        f32x4* kb = (f32x4*)(lds + KB_OFF) + 2 * tid;
        kb[0] = (f32x4){(ex + v0) * ns, (ex + v1) * ns, (ex + v2) * ns, (ex + v3) * ns};
        kb[1] = (f32x4){(ex + v4) * ns, (ex + v5) * ns, (ex + v6) * ns, (ex + v7) * ns};
        __syncthreads();
    }
    const bf16* Pb = (const bf16*)P + (size_t)b * SEQ * PJ + h * 128; bf16* Yb = (bf16*)Y + (size_t)b * SEQ * DM + Y_ATT + h * 128;
#pragma unroll 1
    for (int i = 0; i < 4; ++i) {
        const int qb = (i == 0 ? 15 - s4 : i == 1 ? 8 + s4 : i == 2 ? 7 - s4 : s4);
        fox_block<bf16>(Pb + (size_t)qb * QB * PJ + C_Q, Pb + C_K, Pb + C_V, Pb + (size_t)qb * QB * PJ + C_GA, Yb + (size_t)qb * QB * DM, qb * QB, lds);
    }
}

__global__ void __launch_bounds__(NWAVES * 64, 2) hybrid_fwd(Args a) {
    extern __shared__ __attribute__((aligned(16))) unsigned char lds[];
    const int tid = threadIdx.x, lane = tid & 63, wave = __builtin_amdgcn_readfirstlane(tid >> 6);
    const int G = gridDim.x, bx = blockIdx.x; const int vcu = (G % 8 == 0) ? (bx % 8) * (G / 8) + bx / 8 : bx;
    const int gw = vcu * NWAVES + wave, NGW = G * NWAVES;
    bf16u* WinT = (bf16u*)(a.ws + WS_WIN); bf16u* WoutT = (bf16u*)(a.ws + WS_WOUT); bf16u* Wfg = (bf16u*)(a.ws + WS_WFG); bf16u* PWt = (bf16u*)(a.ws + WS_PWT);
    float* LF = (float*)(a.ws + WS_LF); bf16u* XN = (bf16u*)(a.ws + WS_XN); bf16u* PROJ = (bf16u*)(a.ws + WS_PROJ); bf16u* Y = (bf16u*)(a.ws + WS_Y);
    const int lo = a.ph_lo, hi = a.ph_hi;
#define IN(k) (lo <= (k) && (k) < hi)
#if MK_MULTI_LAUNCH
#define SEAM(k) do { } while (0)
#else
#define SEAM(k) do { if (IN(k) && IN((k) + 1)) { __syncthreads(); cg::this_grid().sync(); } } while (0)
#endif
#define OPQ() int ln_ = lane, gw_ = gw; asm volatile("" : "+v"(ln_)); asm volatile("" : "+s"(gw_))
    if (IN(0)) { OPQ(); prologue_phase(a, (LAS unsigned char*)lds, gw_, NGW, wave, ln_); }
    SEAM(0);
#pragma unroll 1
    for (int l = 0; l < DEPTH; ++l) {
        const int p = 1 + 4 * l;
        if (IN(p)) {
            pg8::Gemm g{XN, WinT + (size_t)l * PJ * DM, MTOK, PJ, DM}; pg8::StaticOrder S; S.init(MTOK, PJ, G, bx);
            pg8::EpiProj E{PROJ, PJ};
            pg8::gemm_phase<pg8::EpiProj, pg8::StaticOrder, true, true>((LAS unsigned char*)lds, g, S, E);
            { OPQ(); fg_phase(XN, Wfg + (size_t)l * 8 * DM, a.b_f + l * NHEAD, LF, gw_, NGW, ln_); }
        }
        SEAM(p);
        if (IN(p + 1)) {
            for (int v = vcu; v < 256; v += G) attn_phase((char*)lds, PROJ, Y, LF, v);
            { OPQ(); conv_phase(PROJ, a.conv_w + (size_t)l * 3 * 512, Y, gw_, NGW, ln_); }
            { OPQ(); pool_phase(PROJ, PWt + (size_t)l * 4 * 16384, a.pool_scale + (size_t)l * 512, Y, gw_, NGW, ln_); }
        }
        SEAM(p + 1);
        if (IN(p + 2)) {
            pg8::Gemm g{Y, WoutT + (size_t)l * DM * DM, MTOK, DM, DM}; pg8::StaticOrder S; S.init(MTOK, DM, G, bx);
            pg8::EpiRes E{l == 0 ? a.x : a.out, a.out, DM, ALPHA};
            pg8::gemm_phase<pg8::EpiRes, pg8::StaticOrder, true, true>((LAS unsigned char*)lds, g, S, E);
        }
        SEAM(p + 2);
        if (IN(p + 3)) { OPQ(); ln_phase(a.out, a.ln_g + (size_t)l * DM, a.ln_b + (size_t)l * DM, XN, gw_, NGW, ln_); }
        SEAM(p + 3);
    }
#undef IN
#undef SEAM
}

extern "C" void kernel_launch(void* const* d_in, const int* in_sizes, int n_in, void* d_out, int out_size, void* d_ws, size_t ws_size, hipStream_t stream) {
    static int grid = 0;
    if (grid == 0) {
        if (n_in != 9 || in_sizes[0] != MTOK * DM || out_size != MTOK * DM || ws_size < WS_END) { fprintf(stderr, "kernel_launch: unexpected shapes (n_in %d, in0 %d, out %d, ws %zu)\n", n_in, n_in > 0 ? in_sizes[0] : -1, out_size, ws_size); grid = -1; return; }
        int dev = 0, cus = 0, per_cu = 0;
        (void)hipGetDevice(&dev); (void)hipDeviceGetAttribute(&cus, hipDeviceAttributeMultiprocessorCount, dev);
        if (hipFuncSetAttribute((const void*)hybrid_fwd, hipFuncAttributeMaxDynamicSharedMemorySize, LDS_BYTES) != hipSuccess) { fprintf(stderr, "kernel_launch: hipFuncSetAttribute failed\n"); grid = -1; return; }
        (void)hipOccupancyMaxActiveBlocksPerMultiprocessor(&per_cu, (const void*)hybrid_fwd, NWAVES * 64, LDS_BYTES);
        (void)hipGetLastError();
        if (per_cu < 1) per_cu = 1;
        grid = cus > 0 ? cus : 256;
    }
    if (grid < 0) return;
    Args a{};
    a.x = (const float*)d_in[0]; a.w_in = (const float*)d_in[1]; a.b_f = (const float*)d_in[2]; a.conv_w = (const float*)d_in[3]; a.pool_w = (const float*)d_in[4];
    a.pool_scale = (const float*)d_in[5]; a.w_out = (const float*)d_in[6]; a.ln_g = (const float*)d_in[7]; a.ln_b = (const float*)d_in[8];
    a.out = (float*)d_out; a.ws = (unsigned char*)d_ws;
    constexpr int NPH = 1 + 4 * DEPTH;
#if MK_MULTI_LAUNCH
    for (int ph = 0; ph < NPH; ++ph) { a.ph_lo = ph; a.ph_hi = ph + 1; hipLaunchKernelGGL(hybrid_fwd, dim3(grid), dim3(NWAVES * 64), LDS_BYTES, stream, a); }
#else
    a.ph_lo = 0; a.ph_hi = NPH;
    void* args[] = {&a};
    hipError_t e = hipLaunchCooperativeKernel((const void*)hybrid_fwd, dim3(grid), dim3(NWAVES * 64), args, LDS_BYTES, stream);
    if (e != hipSuccess) fprintf(stderr, "cooperative launch failed: %s (grid %d)\n", hipGetErrorString(e), grid);
#endif
}
```

```cpp
#include <hip/hip_runtime.h>
#include <hip/hip_bf16.h>
#include <hip/hip_cooperative_groups.h>
#include <cstdio>
#include <cstdint>
namespace cg = cooperative_groups;

#ifndef MK_MULTI_LAUNCH
#define MK_MULTI_LAUNCH 0
#endif

namespace pg8 {
#define PG8_LAS __attribute__((address_space(3)))
typedef unsigned short bf16_t;
typedef short bf16x8 __attribute__((ext_vector_type(8)));
typedef float f32x4 __attribute__((ext_vector_type(4)));
typedef unsigned u32x4 __attribute__((ext_vector_type(4)));
constexpr int BM = 256, BK = 64, HALF = 128, HTB = HALF * BK * 2  , STAGE_BYTES = 8 * HTB, NXCD = 8, WGM = 8;

__host__ __device__ __forceinline__ int lds_byte(int r, int c) { const int st = (r >> 4) * 2 + (c >> 5), rr = r & 15, cc = c & 31, ob = rr * 64 + cc * 2; return st * 1024 + (ob ^ (((ob >> 9) & 1) << 5)); }
__host__ __device__ __forceinline__ void stage_rc(int b, int& R, int& C) { const int st = b / 1024, sb = b % 1024, swz = sb ^ (((sb >> 9) & 1) << 5); R = (st >> 1) * 16 + swz / 64; C = (st & 1) * 32 + (swz % 64) / 2; }
__host__ __device__ __forceinline__ int perm32(int rho) { const int n = rho >> 4, i = rho & 15; return 8 * (i >> 2) + 4 * n + (i & 3); }

struct Unit { int pm, pn; };
struct Gemm { const bf16_t* A; const bf16_t* Bt; int M, N, K; };

struct StaticOrder {
    int nM, nN, nwg, G, c;
    __host__ __device__ void init(int M, int N, int G_, int c_) { nM = M / BM; nN = N / BM; nwg = nM * nN; G = G_; c = c_; }
    __host__ __device__ bool next(int i, Unit& u) const {
        const long L = (long)i * G + c; if (L >= nwg) return false;
        int wgid = (int)L; { const int q = nwg / NXCD, r = nwg % NXCD, xcd = wgid % NXCD, off = wgid / NXCD; wgid = (xcd < r ? xcd * (q + 1) : r * (q + 1) + (xcd - r) * q) + off; }
        const int nig = WGM * nN, gid = wgid / nig, fm = gid * WGM, gsz = (nM - fm) < WGM ? (nM - fm) : WGM;
        u.pm = fm + ((wgid % nig) % gsz); u.pn = (wgid % nig) / gsz; return true;
    }
    __device__ __forceinline__ void a_ready(const Unit&) const {}
    __device__ __forceinline__ void done(const Unit&) const {}
};

__device__ __forceinline__ unsigned cvt_pk_bf16(float lo, float hi) { unsigned r; asm volatile("v_cvt_pk_bf16_f32 %0, %1, %2" : "=v"(r) : "v"(lo), "v"(hi)); return r; }
__device__ __forceinline__ float silu_f(float x) { return x * __builtin_amdgcn_rcpf(1.0f + __builtin_amdgcn_exp2f(-1.4426950408889634f * x)); }
struct EpiProj {
    static constexpr bool PERM = true, AFTER_DRAIN = false;
    bf16_t* O; int ldc;
    __device__ __forceinline__ void operator()(const f32x4 (&acc)[2][2][4][2], const Unit& u, int wr, int wc, int fr, int fq) const {
        const int row0 = u.pm * BM + wr * 64 + fr; const int col0 = u.pn * BM + wc * 32 + 8 * fq;
        const bool gate = (u.pn >= 12 && u.pn < 16) || u.pn == 22 || u.pn == 23 || u.pn >= 26;
#pragma unroll
        for (int ai = 0; ai < 2; ++ai)
#pragma unroll
            for (int m = 0; m < 4; ++m) { bf16_t* rowp = O + (size_t)(row0 + ai * HALF + m * 16) * ldc + col0;
#pragma unroll
                for (int bj = 0; bj < 2; ++bj) { f32x4 v0 = acc[ai][bj][m][0], v1 = acc[ai][bj][m][1];
                    if (gate) { v0 = (f32x4){silu_f(v0[0]), silu_f(v0[1]), silu_f(v0[2]), silu_f(v0[3])}; v1 = (f32x4){silu_f(v1[0]), silu_f(v1[1]), silu_f(v1[2]), silu_f(v1[3])}; }
                    u32x4 w; w.x = cvt_pk_bf16(v0[0], v0[1]); w.y = cvt_pk_bf16(v0[2], v0[3]); w.z = cvt_pk_bf16(v1[0], v1[1]); w.w = cvt_pk_bf16(v1[2], v1[3]);
                    *(u32x4*)(rowp + bj * HALF) = w; } }
    }
};
struct EpiRes {
    static constexpr bool PERM = false, AFTER_DRAIN = false;
    const float* base; float* out; int ldc; float alpha;
    __device__ __forceinline__ void operator()(const f32x4 (&acc)[2][2][4][2], const Unit& u, int wr, int wc, int fr, int fq) const {
        const int col0 = u.pn * BM + wc * 32 + 4 * fq;
#pragma unroll
        for (int ai = 0; ai < 2; ++ai)
#pragma unroll
            for (int m = 0; m < 4; ++m) { const size_t off = (size_t)(u.pm * BM + ai * HALF + wr * 64 + m * 16 + fr) * ldc + col0;
#pragma unroll
                for (int bj = 0; bj < 2; ++bj)
#pragma unroll
                    for (int n = 0; n < 2; ++n) { const f32x4 bs = *(const f32x4*)(base + off + bj * HALF + n * 16); *(f32x4*)(out + off + bj * HALF + n * 16) = bs * alpha + acc[ai][bj][m][n]; }
                asm volatile("" ::: "memory"); }
    }
};
template <class Epi, class Sched, bool ALIGN_EPI = false, bool SP2 = false>
__device__ __forceinline__ void gemm_phase(PG8_LAS unsigned char* lds, const Gemm g, const Sched& S, const Epi& E) {
    int tid = threadIdx.x; asm volatile("" : "+v"(tid));
    const int wid = __builtin_amdgcn_readfirstlane(tid >> 6), lane = tid & 63, wr = wid >> 2, wc = wid & 3, fr = lane & 15, fq = lane >> 4;
    const int K = g.K, nt = K / BK;
    unsigned voffA[2], voffB[2];
#pragma unroll
    for (int i = 0; i < 2; ++i) { int R, C; stage_rc(tid * 16 + i * 8192, R, C); const int Rb = Epi::PERM ? ((R & ~31) + perm32(R & 31)) : R;
        voffA[i] = (unsigned)(R * K + C) * 2u; voffB[i] = (unsigned)(Rb * K + C) * 2u; }
    const size_t kstep = (size_t)(BK * 2);
    const size_t hstep = (size_t)HALF * K * 2;
    const size_t tstep = 2 * hstep;
    const unsigned ldsw = (unsigned)wid * 1024u;
    const int aoff = lds_byte(wr * 64 + fr, fq * 8), boff = lds_byte(wc * 32 + fr, fq * 8);
#define PG8_SA(b, h) (((b) * 2 + (h)) * HTB)
#define PG8_SB(b, h) ((4 + (b) * 2 + (h)) * HTB)
#define PG8_STAGE(bufoff, gbase, voff) do { _Pragma("unroll") for (int _i = 0; _i < 2; ++_i) \
        __builtin_amdgcn_global_load_lds((const unsigned*)((const char*)(gbase) + (voff)[_i]), (PG8_LAS unsigned*)(lds + (bufoff) + ldsw + _i * 8192), 16, 0, 0); } while (0)
#define PG8_LDA(dst, b, h) do { _Pragma("unroll") for (int m = 0; m < 4; ++m) _Pragma("unroll") for (int k = 0; k < 2; ++k) dst[m][k] = *(const PG8_LAS bf16x8*)(lds + PG8_SA(b, h) + aoff + m * 2048 + k * 1024); } while (0)
#define PG8_LDB(dst, b, h) do { _Pragma("unroll") for (int n = 0; n < 2; ++n) _Pragma("unroll") for (int k = 0; k < 2; ++k) dst[n][k] = *(const PG8_LAS bf16x8*)(lds + PG8_SB(b, h) + boff + n * 2048 + k * 1024); } while (0)
#define PG8_MMA(ai, bj, At, Bt) do { __builtin_amdgcn_s_setprio(1); _Pragma("unroll") for (int m = 0; m < 4; ++m) _Pragma("unroll") for (int n = 0; n < 2; ++n) _Pragma("unroll") for (int k = 0; k < 2; ++k) \
        acc[ai][bj][m][n] = __builtin_amdgcn_mfma_f32_16x16x32_bf16(Bt[n][k], At[m][k], acc[ai][bj][m][n], 0, 0, 0); __builtin_amdgcn_s_setprio(0); } while (0)
#define PG8_WAIT_V(n) asm volatile("s_waitcnt vmcnt(" #n ")" ::: "memory")
#define PG8_WAIT_L(n) asm volatile("s_waitcnt lgkmcnt(" #n ")" ::: "memory")
#define PG8_BAR __builtin_amdgcn_s_barrier()
#define PG8_SCHED __builtin_amdgcn_sched_barrier(0)
    Unit cur, nxt; int ui = 0;
    if (!S.next(0, cur)) return;
    f32x4 acc[2][2][4][2];
#pragma unroll
    for (int a = 0; a < 2; ++a)
#pragma unroll
        for (int b = 0; b < 2; ++b)
#pragma unroll
            for (int m = 0; m < 4; ++m)
#pragma unroll
                for (int n = 0; n < 2; ++n) acc[a][b][m][n] = (f32x4){0.f, 0.f, 0.f, 0.f};
    bf16x8 At[4][2], B0[2][2], B1[2][2];
    const char* cA = (const char*)g.A + (size_t)cur.pm * tstep; const char* cB = (const char*)g.Bt + (size_t)cur.pn * tstep;
    S.a_ready(cur);
    if constexpr (SP2) {
        PG8_STAGE(PG8_SB(0, 0), cB, voffB); PG8_STAGE(PG8_SB(0, 1), cB + hstep, voffB); PG8_STAGE(PG8_SA(0, 0), cA, voffA); PG8_STAGE(PG8_SA(0, 1), cA + hstep, voffA);
        if (wr == 1) PG8_BAR;
        PG8_WAIT_V(2); PG8_BAR;
        PG8_STAGE(PG8_SB(1, 0), cB + kstep, voffB); PG8_STAGE(PG8_SA(1, 0), cA + kstep, voffA); PG8_STAGE(PG8_SB(1, 1), cB + hstep + kstep, voffB);
        PG8_WAIT_V(6); PG8_BAR;
    } else {
        PG8_STAGE(PG8_SB(0, 0), cB, voffB); PG8_STAGE(PG8_SA(0, 0), cA, voffA); PG8_STAGE(PG8_SB(0, 1), cB + hstep, voffB); PG8_STAGE(PG8_SA(0, 1), cA + hstep, voffA);
        if (wr == 1) PG8_BAR;
        PG8_WAIT_V(4); PG8_BAR;
        PG8_STAGE(PG8_SB(1, 0), cB + kstep, voffB); PG8_STAGE(PG8_SA(1, 0), cA + kstep, voffA); PG8_STAGE(PG8_SB(1, 1), cB + hstep + kstep, voffB);
        PG8_WAIT_V(6); PG8_BAR;
    }
    for (;;) {
        const bool has_next = S.next(ui + 1, nxt);
        const char* nA = has_next ? (const char*)g.A + (size_t)nxt.pm * tstep : cA; const char* nB = has_next ? (const char*)g.Bt + (size_t)nxt.pn * tstep : cB;
        for (int t = 0; t < nt; t += 2) {
            const bool last = (t == nt - 2);
            const char* a1 = cA + (size_t)(t + 1) * kstep;
            const char* a2 = last ? nA : cA + (size_t)(t + 2) * kstep; const char* b2 = last ? nB : cB + (size_t)(t + 2) * kstep;
            const char* a3 = a2 + kstep; const char* b3 = b2 + kstep;
            if (last && has_next) S.a_ready(nxt);
            if constexpr (SP2) {
            PG8_LDB(B0, 0, 0); PG8_LDB(B1, 0, 1); PG8_SCHED; PG8_LDA(At, 0, 0); PG8_STAGE(PG8_SA(1, 1), a1 + hstep, voffA);
            PG8_WAIT_V(8); PG8_WAIT_L(0); PG8_BAR; PG8_MMA(0, 0, At, B0); PG8_MMA(0, 1, At, B1); PG8_BAR; PG8_SCHED;
            PG8_LDA(At, 0, 1); PG8_STAGE(PG8_SB(0, 0), b2, voffB); PG8_STAGE(PG8_SB(0, 1), b2 + hstep, voffB); PG8_STAGE(PG8_SA(0, 0), a2, voffA);
            PG8_WAIT_V(8); PG8_WAIT_L(0); PG8_BAR; PG8_MMA(1, 0, At, B0); PG8_MMA(1, 1, At, B1); PG8_BAR; PG8_SCHED;
            PG8_LDB(B0, 1, 0); PG8_LDB(B1, 1, 1); PG8_SCHED; PG8_LDA(At, 1, 0); PG8_STAGE(PG8_SA(0, 1), a2 + hstep, voffA);
            PG8_WAIT_V(8); PG8_WAIT_L(0); PG8_BAR; PG8_MMA(0, 0, At, B0); PG8_MMA(0, 1, At, B1); PG8_BAR; PG8_SCHED;
            PG8_LDA(At, 1, 1); PG8_STAGE(PG8_SB(1, 0), b3, voffB); PG8_STAGE(PG8_SB(1, 1), b3 + hstep, voffB); PG8_STAGE(PG8_SA(1, 0), a3, voffA);
            PG8_WAIT_V(8); PG8_WAIT_L(0); PG8_BAR; PG8_MMA(1, 0, At, B0); PG8_MMA(1, 1, At, B1); PG8_BAR; PG8_SCHED;
            } else {
            PG8_LDB(B0, 0, 0); PG8_SCHED; PG8_LDA(At, 0, 0); PG8_STAGE(PG8_SA(1, 1), a1 + hstep, voffA);
            PG8_WAIT_L(8); PG8_BAR; PG8_WAIT_L(0); PG8_MMA(0, 0, At, B0); PG8_BAR; PG8_SCHED;
            PG8_LDB(B1, 0, 1); PG8_STAGE(PG8_SB(0, 0), b2, voffB);
            PG8_BAR; PG8_WAIT_L(0); PG8_MMA(0, 1, At, B1); PG8_BAR;
            PG8_LDA(At, 0, 1); PG8_STAGE(PG8_SA(0, 0), a2, voffA);
            PG8_BAR; PG8_WAIT_L(0); PG8_MMA(1, 0, At, B0); PG8_BAR; PG8_SCHED;
            PG8_STAGE(PG8_SB(0, 1), b2 + hstep, voffB);
            PG8_WAIT_V(6); PG8_BAR; PG8_MMA(1, 1, At, B1); PG8_BAR;
            PG8_LDB(B0, 1, 0); PG8_SCHED; PG8_LDA(At, 1, 0); PG8_STAGE(PG8_SA(0, 1), a2 + hstep, voffA);
            PG8_WAIT_L(8); PG8_BAR; PG8_WAIT_L(0); PG8_MMA(0, 0, At, B0); PG8_BAR; PG8_SCHED;
            PG8_LDB(B1, 1, 1); PG8_STAGE(PG8_SB(1, 0), b3, voffB);
            PG8_BAR; PG8_WAIT_L(0); PG8_MMA(0, 1, At, B1); PG8_BAR;
            PG8_LDA(At, 1, 1); PG8_STAGE(PG8_SA(1, 0), a3, voffA);
            PG8_BAR; PG8_WAIT_L(0); PG8_MMA(1, 0, At, B0); PG8_BAR; PG8_SCHED;
            PG8_STAGE(PG8_SB(1, 1), b3 + hstep, voffB);
            PG8_WAIT_V(6); PG8_BAR; PG8_MMA(1, 1, At, B1); PG8_BAR;
            }
        }
        if constexpr (ALIGN_EPI) { if (wr == 0) PG8_BAR; }
        if constexpr (!Epi::AFTER_DRAIN) { E(acc, cur, wr, wc, fr, fq); S.done(cur); }
        if (!has_next) break;
#pragma unroll
        for (int a = 0; a < 2; ++a)
#pragma unroll
            for (int b = 0; b < 2; ++b)
#pragma unroll
                for (int m = 0; m < 4; ++m)
#pragma unroll
                    for (int n = 0; n < 2; ++n) acc[a][b][m][n] = (f32x4){0.f, 0.f, 0.f, 0.f};
        cur = nxt; cA = nA; cB = nB; ++ui;
        if constexpr (ALIGN_EPI) { if (wr == 1) PG8_BAR; }
    }
    PG8_WAIT_V(0);
    if constexpr (!ALIGN_EPI) { if (wr == 0) PG8_BAR; }
    PG8_BAR;
    if constexpr (Epi::AFTER_DRAIN) { E.fused(acc, cur, wr, wc, fr, fq, lds, wid, lane); S.done(cur); }
#undef PG8_SA
#undef PG8_SB
#undef PG8_STAGE
#undef PG8_LDA
#undef PG8_LDB
#undef PG8_MMA
#undef PG8_WAIT_V
#undef PG8_WAIT_L
#undef PG8_BAR
#undef PG8_SCHED
}
}

namespace att {
constexpr int D = 128, NW = 8, QBLK = 32, KVBLK = 64, QB = NW * QBLK;
constexpr int SHM_V = KVBLK * D * 2, SHM_K = KVBLK * D * 2;
constexpr int LDP = 7168, LDO = 2048;
constexpr float SCALE = 0.08838834764831845f; constexpr float THR = 8.f; constexpr bool WSKIP = false;
constexpr int KB_OFF = 2 * SHM_V + 2 * SHM_K + NW * 64 * 4;
constexpr int SCAN_OFF = KB_OFF + 4096 * 4;
constexpr int OST_OFF = SCAN_OFF + 64;
constexpr int ATT_LDS = OST_OFF + NW * QBLK * D * 2;
using bf16 = __hip_bfloat16;
typedef short bf16x8 __attribute__((ext_vector_type(8)));
typedef short s16x4 __attribute__((ext_vector_type(4)));
typedef float f32x16 __attribute__((ext_vector_type(16)));
typedef float f32x4 __attribute__((ext_vector_type(4)));
typedef unsigned u32x4 __attribute__((ext_vector_type(4)));
template <class A, class Bt> struct same_t { static constexpr bool v = false; };
template <class A> struct same_t<A, A> { static constexpr bool v = true; };
#define KSWZ(row, colB) ((row) * 256 + ((colB) ^ (((row) & 7) << 4)))
#define SBAR() __builtin_amdgcn_sched_barrier(0)
__device__ __forceinline__ int v_st(int k, int c) { const int kk = (k & ~0xC) | ((k & 4) << 1) | ((k & 8) >> 1); return ((kk >> 3) * 4 + (c >> 5)) * 512 + ((kk & 7) * 32 + (c & 31)) * 2; }
__device__ __forceinline__ int v_rd_base(int lane) { return ((lane & 3) << 3) | (((lane >> 2) & 3) << 6) | (((lane >> 4) & 1) << 5) | (((lane >> 5) & 1) << 8); }
constexpr int v_rd_off(int d0, int ks, int half) { return d0 * 512 + ks * 4096 + half * 2048; }
__device__ __forceinline__ int crow(int r, int hi) { return (r & 3) + 8 * (r >> 2) + 4 * hi; }
__device__ __forceinline__ unsigned cvtpk(float lo, float hi) {
    unsigned r; asm volatile("v_cvt_pk_bf16_f32 %0, %1, %2" : "=v"(r) : "v"(lo), "v"(hi)); return r;
}
__device__ __forceinline__ bf16x8 pack8(f32x4 a, f32x4 b) {
    u32x4 w = {cvtpk(a[0], a[1]), cvtpk(a[2], a[3]), cvtpk(b[0], b[1]), cvtpk(b[2], b[3])};
    return *reinterpret_cast<bf16x8*>(&w);
}
template <class T> __device__ __forceinline__ bf16x8 load8(const T* p) {
    if constexpr (same_t<T, float>::v) { return pack8(*(const f32x4*)p, *(const f32x4*)(p + 4)); }
    else { return *reinterpret_cast<const bf16x8*>(p); }
}
__device__ __forceinline__ void mask_tile(f32x16& p0, f32x16& p1, int dq, unsigned W) {
    const float NEG = -__builtin_inff();
#pragma unroll
    for (int r = 0; r < 16; ++r) {
        const int c = (r & 3) + 8 * (r >> 2);
        if ((unsigned)(dq - c) >= W) p0[r] = NEG;
        if ((unsigned)(dq - c - 32) >= W) p1[r] = NEG;
    }
}
__device__ __forceinline__ void partialSM(f32x16& p0, f32x16& p1, float& m_reg, float& mn, float& alpha) {
    float pmax = p0[0]; for (int r = 1; r < 16; ++r) pmax = fmaxf(pmax, p0[r]); for (int r = 0; r < 16; ++r) pmax = fmaxf(pmax, p1[r]);
    { auto rr = __builtin_amdgcn_permlane32_swap(__float_as_uint(pmax), __float_as_uint(pmax), false, false);
      pmax = fmaxf(__uint_as_float(rr[0]), __uint_as_float(rr[1])); }
    constexpr float C2 = 1.4426950408889634f * SCALE;
    if (__builtin_expect(__all((pmax - m_reg) * SCALE <= THR), 1)) { mn = m_reg; alpha = 1.f; }
    else { mn = fmaxf(m_reg, pmax); alpha = __builtin_amdgcn_exp2f((m_reg - mn) * C2); m_reg = mn; }
    const float mnL = -mn * C2;
    for (int r = 0; r < 16; ++r) p0[r] = fmaf(p0[r], C2, mnL); for (int r = 0; r < 16; ++r) p1[r] = fmaf(p1[r], C2, mnL);
    for (int r = 0; r < 16; ++r) p0[r] = __builtin_amdgcn_exp2f(p0[r]);
}
__device__ __forceinline__ void finishSM(f32x16& p0, f32x16& p1, float alpha, float& l_reg, bf16x8& pa0, bf16x8& pa1, bf16x8& pa2, bf16x8& pa3) {
    for (int r = 0; r < 16; ++r) p1[r] = __builtin_amdgcn_exp2f(p1[r]);
    float ps = 0; for (int r = 0; r < 16; ++r) ps += p0[r]; for (int r = 0; r < 16; ++r) ps += p1[r];
    { auto rr = __builtin_amdgcn_permlane32_swap(__float_as_uint(ps), __float_as_uint(ps), false, false);
      ps = __uint_as_float(rr[0]) + __uint_as_float(rr[1]); }
    l_reg = l_reg * alpha + ps;
#define PK4(P, B_, OUT) do { unsigned a0 = cvtpk(P[B_+0], P[B_+1]), a1 = cvtpk(P[B_+2], P[B_+3]);                          \
        unsigned b0 = cvtpk(P[B_+4], P[B_+5]), b1 = cvtpk(P[B_+6], P[B_+7]);                                             \
        auto r0 = __builtin_amdgcn_permlane32_swap(a0, b0, false, false); auto r1 = __builtin_amdgcn_permlane32_swap(a1, b1, false, false); \
        u32x4 w = {r0[0], r1[0], r0[1], r1[1]}; OUT = *reinterpret_cast<bf16x8*>(&w); } while (0)
    PK4(p0, 0, pa0); PK4(p0, 8, pa1); PK4(p1, 0, pa2); PK4(p1, 8, pa3);
#undef PK4
}
template <int KB, bool SK>
__device__ __forceinline__ void qkt(f32x16& p0, f32x16& p1, const char* K_lds, int r32, int hi, const bf16x8* qr, bool act) {
    if (SK && !act) { const float NEG = -__builtin_inff();
#pragma unroll
        for (int r = 0; r < 16; ++r) { p0[r] = NEG; p1[r] = NEG; } return; }
    p0 = f32x16{}; p1 = f32x16{};
    const char* kb[4];
#pragma unroll
    for (int dd = 0; dd < 4; ++dd) kb[dd] = K_lds + KB * SHM_K + KSWZ(r32, (dd * 16 + hi * 8) * 2);
#pragma unroll
    for (int d0 = 0; d0 < 8; ++d0) { const char* a = kb[d0 & 3] + (d0 >> 2) * 128;
        bf16x8 b0 = *reinterpret_cast<const bf16x8*>(a);
        bf16x8 b1 = *reinterpret_cast<const bf16x8*>(a + 32 * 256);
        p0 = __builtin_amdgcn_mfma_f32_32x32x16_bf16(b0, qr[d0], p0, 0, 0, 0);
        p1 = __builtin_amdgcn_mfma_f32_32x32x16_bf16(b1, qr[d0], p1, 0, 0, 0); }
}
template <int VB, bool SK>
__device__ __forceinline__ void pv_tile(f32x16* o, int vb0, bf16x8 pa0, bf16x8 pa1, bf16x8 pa2, bf16x8 pa3, bool act) {
    if (SK && !act) return;
#define TRRD(dst, off) asm volatile("ds_read_b64_tr_b16 %0, %1 offset:%2" : "=&v"(dst) : "v"(vb0), "i"(off) : "memory")
#define PV_D0(d0) do { s16x4 l0, l1, l2, l3, h0, h1, h2, h3; constexpr int b_ = VB * SHM_V + v_rd_off(d0, 0, 0);     \
        TRRD(l0, b_); TRRD(h0, b_ + 2048); TRRD(l1, b_ + 4096); TRRD(h1, b_ + 6144); TRRD(l2, b_ + 8192); TRRD(h2, b_ + 10240); TRRD(l3, b_ + 12288); TRRD(h3, b_ + 14336); \
        asm volatile("s_waitcnt lgkmcnt(0)" ::: "memory"); SBAR();                 \
        o[d0] = __builtin_amdgcn_mfma_f32_32x32x16_bf16(pa0, (bf16x8){l0[0], l0[1], l0[2], l0[3], h0[0], h0[1], h0[2], h0[3]}, o[d0], 0, 0, 0);   \
        o[d0] = __builtin_amdgcn_mfma_f32_32x32x16_bf16(pa1, (bf16x8){l1[0], l1[1], l1[2], l1[3], h1[0], h1[1], h1[2], h1[3]}, o[d0], 0, 0, 0);   \
        o[d0] = __builtin_amdgcn_mfma_f32_32x32x16_bf16(pa2, (bf16x8){l2[0], l2[1], l2[2], l2[3], h2[0], h2[1], h2[2], h2[3]}, o[d0], 0, 0, 0);   \
        o[d0] = __builtin_amdgcn_mfma_f32_32x32x16_bf16(pa3, (bf16x8){l3[0], l3[1], l3[2], l3[3], h3[0], h3[1], h3[2], h3[3]}, o[d0], 0, 0, 0); } while (0)
    PV_D0(0); PV_D0(1); PV_D0(2); PV_D0(3);
#undef PV_D0
#undef TRRD
}
template <class TIn, class TOut> struct BlockRef { const TIn* Q; const TIn* K; const TIn* V; const TIn* G; TOut* O; int P0; };
template <class TIn> struct Seam {
    bf16x8 qr[8];
    bf16x8 st_k0, st_k1;
};
__device__ __forceinline__ int swa_jlo(int P0, int W) { const int lowk = P0 - W + 1; return lowk > 0 ? lowk / KVBLK : 0; }
#define ROW(p, k0, rr) ((const TIn*)((const char*)((p) + (size_t)(k0) * LDP) + ((rr) == sr ? vo0 : vo1)))
#define VMW() asm volatile("s_waitcnt vmcnt(0)" ::: "memory")
#define VMWN(n) asm volatile("s_waitcnt vmcnt(%0)" :: "i"(n) : "memory")
#define SLOAD_H(Kp, Vp, k0) do { } while (0)
#define SWRITE_HK(bf) do { *(bf16x8*)(K_lds + (bf) * SHM_K + kws) = S.st_k0; *(bf16x8*)(K_lds + (bf) * SHM_K + kws + 32 * 256) = S.st_k1; } while (0)
#define SWRITE_HV(bf) do { } while (0)
#define SWRITE_H(bf) do { SWRITE_HV(bf); SWRITE_HK(bf); } while (0)
#define SLOAD_F(p, k0) do { S.st_k0 = load8<TIn>(ROW(p, k0, sr)); S.st_k1 = load8<TIn>(ROW(p, k0, 32 + sr)); } while (0)
#define SWRITE_KF(bf) do { *(bf16x8*)(K_lds + (bf) * SHM_K + kws) = S.st_k0; *(bf16x8*)(K_lds + (bf) * SHM_K + kws + 32 * 256) = S.st_k1; } while (0)
#define SWRITE_VF(bf) do { *(bf16x8*)(V_lds + (bf) * SHM_V + vst0) = S.st_k0; *(bf16x8*)(V_lds + (bf) * SHM_V + vst1) = S.st_k1; } while (0)
template <class TIn, class TOut>
__device__ __forceinline__ void causal_swa_prime(const BlockRef<TIn, TOut>& cur, int W, char* lds, Seam<TIn>& S) {
    constexpr bool F32 = true;
    int tid = threadIdx.x; asm volatile("" : "+v"(tid));
    const int wid = __builtin_amdgcn_readfirstlane(tid >> 6), lane = tid & 63, r32 = lane & 31, hi = lane >> 5;
    const int sr = tid >> 4, sc = (tid & 15) * 8, kws = KSWZ(sr, sc * 2); char* K_lds = lds + 2 * SHM_V;
    const unsigned vo0 = (unsigned)(sr * LDP + sc) * 2u, vo1 = vo0 + 32u * LDP * 2u;
    const int kb0 = ((cur.P0 + QB) / KVBLK - 1) * KVBLK;
    { const unsigned qo = (unsigned)(r32 * LDP + hi * 8) * 2u; const char* qb_ = (const char*)(cur.Q + (size_t)(wid * QBLK) * LDP);
      for (int d0 = 0; d0 < 8; ++d0) S.qr[d0] = load8<TIn>((const TIn*)(qb_ + qo) + d0 * 16); }
    if constexpr (F32) { SLOAD_F(cur.K, kb0); VMW(); SWRITE_KF(0); SBAR(); SLOAD_F(cur.V, kb0); }
    else { SLOAD_H(cur.K, cur.V, kb0); VMW(); SWRITE_HK(0); }
    __syncthreads();
}
template <class TIn, class TOut>
__device__ __forceinline__ void causal_swa_block(const BlockRef<TIn, TOut>& cur, const BlockRef<TIn, TOut>& nxt, int skv, int W, char* lds, Seam<TIn>& S) {
    constexpr bool F32 = true;
    int tid = threadIdx.x; asm volatile("" : "+v"(tid));
    const int wid = __builtin_amdgcn_readfirstlane(tid >> 6), lane = tid & 63, r32 = lane & 31, hi = lane >> 5;
    const int j_lo = swa_jlo(cur.P0, W);
    int j_hi = (cur.P0 + QB - 1) / KVBLK + 1; if (j_hi > skv / KVBLK) j_hi = skv / KVBLK;
    const int NT = j_hi - j_lo;
    const int kbn = ((nxt.P0 + QB) / KVBLK - 1) * KVBLK;
    const int qlo = cur.P0 + wid * QBLK, qm = qlo + r32 - 4 * hi;
    char* V_lds = lds; char* K_lds = lds + 2 * SHM_V;
    float* ws = (float*)(lds + 2 * SHM_V + 2 * SHM_K) + wid * 64; float* li_l = ws, * al_l = ws + 32;
    const float* kbl = (const float*)(lds + KB_OFF) + 4 * hi;
    float m_reg = -1e30f, l_reg = 0; f32x16 o[4] = {};
    const unsigned vo0 = (unsigned)((tid >> 4) * LDP + (tid & 15) * 8) * 2u, vo1 = vo0 + 32u * LDP * 2u;
    const int sr = tid >> 4, sc = (tid & 15) * 8, vst0 = v_st(sr, sc), vst1 = v_st(32 + sr, sc), kws = KSWZ(sr, sc * 2);
    const int vb0 = (int)(uintptr_t)V_lds + v_rd_base(lane);
    const TIn* Kh = cur.K; const TIn* Vh = cur.V;
#define RESC(a) do { if (__any((a) < 1.f)) { if (hi == 0) al_l[r32] = (a); asm volatile("s_waitcnt lgkmcnt(0)" ::: "memory");              \
                     for (int d_ = 0; d_ < 4; ++d_) for (int r = 0; r < 16; ++r) o[d_][r] *= al_l[crow(r, hi)]; } } while (0)
#define KBASE(t) ((j_hi - 1 - (t)) * KVBLK)
#define ACT(t) (KBASE(t) <= qlo + QBLK - 1 && KBASE(t) + KVBLK - 1 >= qlo - W + 1)
#define MASKT(P0_, P1_, t) do { const int kb_ = KBASE(t); if ((!SK || ACT(t)) && (kb_ + KVBLK - 1 > qlo || kb_ <= qlo + QBLK - 1 - W)) mask_tile(P0_, P1_, qm - kb_, (unsigned)W); } while (0)
#define ADDB(P0_, P1_, t) do { const f32x4* kb4_ = (const f32x4*)(kbl + KBASE(t)); _Pragma("unroll") for (int g_ = 0; g_ < 4; ++g_) { const f32x4 a_ = kb4_[2 * g_], b_ = kb4_[8 + 2 * g_]; \
        _Pragma("unroll") for (int e_ = 0; e_ < 4; ++e_) { P0_[4 * g_ + e_] += a_[e_]; P1_[4 * g_ + e_] += b_[e_]; } } } while (0)
    constexpr int NQL = 8;
    constexpr bool SK = WSKIP && !F32;
#define SEAM_K0() do { VMWN(NQL); if constexpr (F32) { SWRITE_KF(0); SBAR(); SLOAD_F(nxt.V, kbn); } else { SWRITE_HK(0); } SBAR(); } while (0)
    f32x16 pA0, pA1, pB0, pB1; float mnA, mnB, alA, alB; bf16x8 pa0, pa1, pa2, pa3;
    if constexpr (F32) { VMW(); SWRITE_VF(0); SBAR(); } else { SWRITE_HV(0); SBAR(); }
    if (NT > 1) { if constexpr (F32) SLOAD_F(Kh, KBASE(1)); else SLOAD_H(Kh, Vh, KBASE(1)); }
    SBAR(); qkt<0, SK>(pA0, pA1, K_lds, r32, hi, S.qr, ACT(0));
    if constexpr (F32) { if (NT > 1) { VMW(); SWRITE_KF(1); SBAR(); SLOAD_F(Vh, KBASE(1)); } }
    ADDB(pA0, pA1, 0); MASKT(pA0, pA1, 0); partialSM(pA0, pA1, m_reg, mnA, alA);
    if (NT > 1) { VMW(); if constexpr (F32) { SWRITE_VF(1); SBAR(); if (NT > 2) SLOAD_F(Kh, KBASE(2)); } else SWRITE_H(1); }
    __syncthreads();
#define HALF_STEP(PX0, PX1, mnX, alX, PY0, PY1, alY, t, KB, VB, SB) do {                                                      \
        SBAR(); qkt<KB, SK>(PX0, PX1, K_lds, r32, hi, S.qr, ACT(t));                                             \
        finishSM(PY0, PY1, alY, l_reg, pa0, pa1, pa2, pa3); SBAR();                                                           \
        if ((t) + 1 < NT) { if constexpr (F32) { VMW(); SWRITE_KF(SB); SBAR(); SLOAD_F(Vh, KBASE((t) + 1)); }  \
                            else { SLOAD_H(Kh, Vh, KBASE((t) + 1)); } SBAR(); }                                               \
        pv_tile<VB, SK>(o, vb0, pa0, pa1, pa2, pa3, ACT((t) - 1)); ADDB(PX0, PX1, (t)); MASKT(PX0, PX1, (t)); partialSM(PX0, PX1, m_reg, mnX, alX);                                        \
        __syncthreads();                                                                                                      \
        if ((t) + 1 < NT) { VMW(); if constexpr (F32) { SWRITE_VF(SB); SBAR(); if ((t) + 2 < NT) SLOAD_F(Kh, KBASE((t) + 2)); } \
                            else { SWRITE_H(SB); } }                                                                          \
        RESC(alX); __syncthreads(); } while (0)
    for (int t = 1; t + 1 < NT; t += 2) {
        HALF_STEP(pB0, pB1, mnB, alB, pA0, pA1, alA, t, 1, 0, 0);
        HALF_STEP(pA0, pA1, mnA, alA, pB0, pB1, alB, t + 1, 0, 1, 1);
    }
    const bool even = (NT & 1) == 0;
    if (even) { SBAR(); qkt<1, SK>(pB0, pB1, K_lds, r32, hi, S.qr, ACT(NT - 1)); SBAR(); }
#define QROW(e) (nxt.Q + (size_t)(wid * QBLK + r32) * LDP + ((e) >> 1) * 16 + hi * 8 + ((e) & 1) * 4)
    { SLOAD_F(nxt.K, kbn); SBAR();
#pragma unroll
        for (int d0 = 0; d0 < 8; ++d0) S.qr[d0] = load8<TIn>((const TIn*)((const char*)(nxt.Q + (size_t)(wid * QBLK) * LDP) + (unsigned)(r32 * LDP + hi * 8) * 2u) + d0 * 16); }
    SBAR();
    finishSM(pA0, pA1, alA, l_reg, pa0, pa1, pa2, pa3); SBAR();
#undef QROW
    pv_tile<0, SK>(o, vb0, pa0, pa1, pa2, pa3, ACT(even ? NT - 2 : NT - 1));
    if (even) { ADDB(pB0, pB1, NT - 1); MASKT(pB0, pB1, NT - 1); partialSM(pB0, pB1, m_reg, mnB, alB); __syncthreads(); RESC(alB);
        finishSM(pB0, pB1, alB, l_reg, pa0, pa1, pa2, pa3); SBAR(); pv_tile<1, SK>(o, vb0, pa0, pa1, pa2, pa3, ACT(NT - 1)); }
    SBAR(); SEAM_K0();
    if (hi == 0) li_l[r32] = l_reg; asm volatile("s_waitcnt lgkmcnt(0)" ::: "memory");
    float rli[16];
#pragma unroll
    for (int r = 0; r < 16; ++r) rli[r] = __builtin_amdgcn_rcpf(li_l[crow(r, hi)]);
    {
        unsigned le = (unsigned)lane; asm volatile("" : "+v"(le));
        const unsigned r32e = le & 31u, hie = le >> 5;
        unsigned short* stg = (unsigned short*)(lds + OST_OFF) + wid * (QBLK * D);
#pragma unroll
        for (int r = 0; r < 16; ++r) { const int orow = crow(r, hi);
#pragma unroll
            for (int d0 = 0; d0 < 4; ++d0) { const float v = o[d0][r] * rli[r]; stg[(((r & 3) + 8 * (r >> 2)) * D + d0 * 32) + (4 * D * hie + r32e)] = (unsigned short)(cvtpk(v, 0.f) & 0xffffu); } }
        asm volatile("s_waitcnt lgkmcnt(0)" ::: "memory");
        const unsigned go = ((le >> 4) * LDP + (le & 15u) * 8u) * 2u, oo = ((le >> 4) * LDO + (le & 15u) * 8u) * 2u, so = (le >> 4) * D + (le & 15u) * 8u;
#pragma unroll
        for (int i = 0; i < 8; ++i) {
            const u32x4 ov = *(const u32x4*)(stg + i * 4 * D + so);
            const u32x4 gv = *(const u32x4*)((const char*)(cur.G + (size_t)(wid * QBLK + i * 4) * LDP) + go);
            u32x4 w;
#pragma unroll
            for (int e = 0; e < 4; ++e) w[e] = cvtpk(__uint_as_float(ov[e] << 16) * __uint_as_float(gv[e] << 16), __uint_as_float(ov[e] & 0xffff0000u) * __uint_as_float(gv[e] & 0xffff0000u));
            *(u32x4*)((char*)(cur.O + (size_t)(wid * QBLK + i * 4) * LDO) + oo) = w;
            if (i & 1) asm volatile("" ::: "memory"); }
    }
    __syncthreads();
#undef RESC
#undef KBASE
#undef ACT
#undef MASKT
#undef ADDB
#undef SEAM_K0
#undef HALF_STEP
}
#undef ROW
#undef VMW
#undef VMWN
#undef SLOAD_H
#undef SWRITE_HK
#undef SWRITE_HV
#undef SWRITE_H
#undef SLOAD_F
#undef SWRITE_KF
#undef SWRITE_VF

}

constexpr int DM = 2048, NBATCH = 8, SEQ = 4096, DEPTH = 4, MTOK = NBATCH * SEQ, NHEAD = 8;
constexpr int INW = 7176, PJ = 7168;
constexpr int C_Q = 0, C_K = 1024, C_V = 2048, C_GA = 3072, C_CB = 4096, C_CC = 4608, C_CH = 5120, C_GC = 5632, C_PU = 6144, C_GP = 6656;
constexpr int Y_ATT = 0, Y_CONV = 1024, Y_POOL = 1536;
constexpr float LN_EPS = 1e-5f;
constexpr float ALPHA = 1.6817928305074290f;
constexpr size_t MiB = 1u << 20;
constexpr size_t WS_WIN = 0, WS_WOUT = 112 * MiB, WS_WFG = 144 * MiB, WS_PWT = 145 * MiB, WS_LF = 146 * MiB, WS_XN = 148 * MiB, WS_PROJ = 276 * MiB, WS_Y = 724 * MiB, WS_END = 852 * MiB;
constexpr int LDS_BYTES = 155648;
static_assert(att::ATT_LDS <= LDS_BYTES, "LDS map");
constexpr int NWAVES = 8;

typedef unsigned short bf16u;
typedef float f32x4 __attribute__((ext_vector_type(4)));
typedef unsigned u32x4 __attribute__((ext_vector_type(4)));
typedef unsigned u32x2 __attribute__((ext_vector_type(2)));
typedef short bf16x8 __attribute__((ext_vector_type(8)));
#define LAS __attribute__((address_space(3)))
__device__ __forceinline__ unsigned pk2(float lo, float hi) { unsigned r; asm volatile("v_cvt_pk_bf16_f32 %0, %1, %2" : "=v"(r) : "v"(lo), "v"(hi)); return r; }
__device__ __forceinline__ float bflo(unsigned w) { return __uint_as_float(w << 16); }
__device__ __forceinline__ float bfhi(unsigned w) { return __uint_as_float(w & 0xffff0000u); }
__device__ __forceinline__ float wave_sum(float v) {
#pragma unroll
    for (int o = 1; o < 64; o <<= 1) v += __shfl_xor(v, o);
    return v;
}

struct Args { const float* x; const float* w_in; const float* b_f; const float* conv_w; const float* pool_w; const float* pool_scale; const float* w_out; const float* ln_g; const float* ln_b;
              float* out; unsigned char* ws; int ph_lo, ph_hi; };

__device__ __forceinline__ void transpose_item(const float* W, int ldw, int K, int src_n0, bf16u* WT, int dst_n0, int k0, LAS float* scr, int lane) {
#pragma unroll 8
    for (int i = 0; i < 32; ++i) { const int kk = 2 * i + (lane >> 5); scr[kk * 33 + (lane & 31)] = W[(size_t)(k0 + kk) * ldw + src_n0 + (lane & 31)]; }
    asm volatile("s_waitcnt lgkmcnt(0)" ::: "memory");
    const int c = lane & 7;
#pragma unroll
    for (int j = 0; j < 4; ++j) { const int n = (lane >> 3) + 8 * j; const LAS float* s = scr + (8 * c) * 33 + n;
        u32x4 o; o.x = pk2(s[0 * 33], s[1 * 33]); o.y = pk2(s[2 * 33], s[3 * 33]); o.z = pk2(s[4 * 33], s[5 * 33]); o.w = pk2(s[6 * 33], s[7 * 33]);
        *(u32x4*)(WT + (size_t)(dst_n0 + n) * K + k0 + 8 * c) = o; }
    asm volatile("s_waitcnt lgkmcnt(0)" ::: "memory");
}
__device__ __forceinline__ void prologue_phase(const Args& a, LAS unsigned char* lds, int gw, int NGW, int wave, int lane) {
    LAS float* scr = (LAS float*)(lds + wave * 16384);
    bf16u* WinT = (bf16u*)(a.ws + WS_WIN); bf16u* WoutT = (bf16u*)(a.ws + WS_WOUT); bf16u* Wfg = (bf16u*)(a.ws + WS_WFG); bf16u* PWt = (bf16u*)(a.ws + WS_PWT); bf16u* XN = (bf16u*)(a.ws + WS_XN);
    constexpr int I_IN = (DM / 64) * (PJ / 32), I_OUT = (DM / 64) * (DM / 32);
    for (int it = gw; it < DEPTH * (I_IN + I_OUT); it += NGW) {
        const int l = it / (I_IN + I_OUT); int r = it % (I_IN + I_OUT);
        if (r < I_IN) { const int nblk = PJ / 32, kb = r / nblk, nb = r % nblk, n0 = 32 * nb;
            transpose_item(a.w_in + (size_t)l * DM * INW, INW, DM, n0 + (n0 >= 4096 ? 8 : 0), WinT + (size_t)l * PJ * DM, n0, 64 * kb, scr, lane); }
        else { r -= I_IN; const int nblk = DM / 32, kb = r / nblk, nb = r % nblk;
            transpose_item(a.w_out + (size_t)l * DM * DM, DM, DM, 32 * nb, WoutT + (size_t)l * DM * DM, 32 * nb, 64 * kb, scr, lane); }
    }
    const int gt = gw * 64 + lane, NGT = NGW * 64;
    for (int e = gt; e < DEPTH * 8 * DM; e += NGT) { const int l = e / (8 * DM), n = (e / DM) & 7, k = e % DM;
        const float v = a.w_in[(size_t)l * DM * INW + (size_t)k * INW + 4096 + n]; Wfg[e] = (bf16u)(pk2(v, 0.f) & 0xffffu); }
    for (int e = gt; e < DEPTH * 4 * 128 * 128; e += NGT) { const int lg = e >> 14, d = (e >> 7) & 127, c = e & 127;
        const float v = a.pool_w[(size_t)lg * 16384 + c * 128 + d]; PWt[e] = (bf16u)(pk2(v, 0.f) & 0xffffu); }
    for (size_t e = (size_t)gt; e < (size_t)MTOK * DM / 8; e += NGT) { const f32x4 v0 = ((const f32x4*)a.x)[2 * e], v1 = ((const f32x4*)a.x)[2 * e + 1];
        u32x4 o; o.x = pk2(v0[0], v0[1]); o.y = pk2(v0[2], v0[3]); o.z = pk2(v1[0], v1[1]); o.w = pk2(v1[2], v1[3]); ((u32x4*)XN)[e] = o; }
}

__device__ __forceinline__ void fg_phase(const bf16u* XN, const bf16u* Wfg, const float* bf, float* LF, int gw, int NGW, int lane) {
    typedef float f4 __attribute__((ext_vector_type(4)));
    const int fr = lane & 15, fq = lane >> 4;
    for (int t = gw; t < MTOK / 16; t += NGW) {
        const bf16u* xr = XN + (size_t)(t * 16 + fr) * DM + fq * 32; const bf16u* wr_ = Wfg + (size_t)(fr & 7) * DM + fq * 32;
        f4 acc = {0.f, 0.f, 0.f, 0.f};
#pragma unroll 2
        for (int kc = 0; kc < DM; kc += 128) {
            bf16x8 xa[4], wb[4];
#pragma unroll
            for (int j = 0; j < 4; ++j) { xa[j] = *(const bf16x8*)(xr + kc + j * 8); wb[j] = *(const bf16x8*)(wr_ + kc + j * 8); }
#pragma unroll
            for (int j = 0; j < 4; ++j) acc = __builtin_amdgcn_mfma_f32_16x16x32_bf16(wb[j], xa[j], acc, 0, 0, 0);
        }
        if (fq < 2) { const int tok = t * 16 + fr, b = tok / SEQ, s = tok % SEQ;
#pragma unroll
            for (int e = 0; e < 4; ++e) { const int h = 4 * fq + e; const float z = acc[e] + bf[h];
                const float lf = fminf(z, 0.f) - log1pf(__expf(-fabsf(z)));
                LF[(size_t)(b * NHEAD + h) * SEQ + s] = lf; } }
    }
}

__device__ __forceinline__ void conv_phase(const bf16u* P, const float* cw, bf16u* Y, int gw, int NGW, int lane) {
    const int c0 = lane * 8;
    float w0[8], w1[8], w2[8];
#pragma unroll
    for (int j = 0; j < 8; ++j) { w0[j] = cw[c0 + j]; w1[j] = cw[512 + c0 + j]; w2[j] = cw[1024 + c0 + j]; }
    for (int t = gw; t < MTOK / 16; t += NGW) {
        const int tok0 = t * 16; const bool first = (tok0 % SEQ) == 0;
        float u1[8], u2[8];
#pragma unroll
        for (int j = 0; j < 8; ++j) { u1[j] = 0.f; u2[j] = 0.f; }
        if (!first) {
            const u32x4 c1 = *(const u32x4*)(P + (size_t)(tok0 - 1) * PJ + C_CC + c0), h1 = *(const u32x4*)(P + (size_t)(tok0 - 1) * PJ + C_CH + c0);
            const u32x4 c2 = *(const u32x4*)(P + (size_t)(tok0 - 2) * PJ + C_CC + c0), h2 = *(const u32x4*)(P + (size_t)(tok0 - 2) * PJ + C_CH + c0);
#pragma unroll
            for (int j = 0; j < 4; ++j) { u1[2 * j] = bflo(c1[j]) * bflo(h1[j]); u1[2 * j + 1] = bfhi(c1[j]) * bfhi(h1[j]); u2[2 * j] = bflo(c2[j]) * bflo(h2[j]); u2[2 * j + 1] = bfhi(c2[j]) * bfhi(h2[j]); }
        }
#pragma unroll 4
        for (int i = 0; i < 16; ++i) {
            const bf16u* row = P + (size_t)(tok0 + i) * PJ + c0;
            const u32x4 cc = *(const u32x4*)(row + C_CC), hh = *(const u32x4*)(row + C_CH), bb = *(const u32x4*)(row + C_CB), gg = *(const u32x4*)(row + C_GC);
            float u0[8], y[8];
#pragma unroll
            for (int j = 0; j < 4; ++j) { u0[2 * j] = bflo(cc[j]) * bflo(hh[j]); u0[2 * j + 1] = bfhi(cc[j]) * bfhi(hh[j]); }
#pragma unroll
            for (int j = 0; j < 4; ++j) {
                y[2 * j]     = bflo(bb[j]) * (w0[2 * j] * u2[2 * j] + w1[2 * j] * u1[2 * j] + w2[2 * j] * u0[2 * j]) * bflo(gg[j]);
                y[2 * j + 1] = bfhi(bb[j]) * (w0[2 * j + 1] * u2[2 * j + 1] + w1[2 * j + 1] * u1[2 * j + 1] + w2[2 * j + 1] * u0[2 * j + 1]) * bfhi(gg[j]); }
            u32x4 o; o.x = pk2(y[0], y[1]); o.y = pk2(y[2], y[3]); o.z = pk2(y[4], y[5]); o.w = pk2(y[6], y[7]);
            *(u32x4*)(Y + (size_t)(tok0 + i) * DM + Y_CONV + c0) = o;
#pragma unroll
            for (int j = 0; j < 8; ++j) { u2[j] = u1[j]; u1[j] = u0[j]; }
        }
    }
}

template <int G, int WIN>
__device__ __forceinline__ void pool_group(const bf16u* P, const bf16u* PWt, const float* ps, bf16u* Y, int tok0, int lane) {
    typedef float f4 __attribute__((ext_vector_type(4)));
    const int fr = lane & 15, fq = lane >> 4, tok = tok0 + fr, s = tok % SEQ;
    const int cnt = (s + 1 < WIN) ? s + 1 : WIN; const float rc = 1.0f / (float)cnt;
    f4 acc[8];
#pragma unroll
    for (int nb = 0; nb < 8; ++nb) acc[nb] = (f4){0.f, 0.f, 0.f, 0.f};
#pragma unroll 1
    for (int ks = 0; ks < 4; ++ks) {
        const bf16u* up = P + (size_t)tok * PJ + C_PU + G * 128 + ks * 32 + fq * 8;
        float sum[8], cur[8];
        { const u32x4 v = *(const u32x4*)up;
#pragma unroll
          for (int j = 0; j < 4; ++j) { cur[2 * j] = bflo(v[j]); cur[2 * j + 1] = bfhi(v[j]); sum[2 * j] = cur[2 * j]; sum[2 * j + 1] = cur[2 * j + 1]; } }
#pragma unroll
        for (int i = 1; i < WIN; ++i) { if (i < cnt) { const u32x4 v = *(const u32x4*)(up - (size_t)i * PJ);
#pragma unroll
            for (int j = 0; j < 4; ++j) { sum[2 * j] += bflo(v[j]); sum[2 * j + 1] += bfhi(v[j]); } }
            if ((i & 3) == 3) asm volatile("" ::: "memory"); }
        u32x4 zw;
        zw.x = pk2(sum[0] * rc - cur[0], sum[1] * rc - cur[1]); zw.y = pk2(sum[2] * rc - cur[2], sum[3] * rc - cur[3]);
        zw.z = pk2(sum[4] * rc - cur[4], sum[5] * rc - cur[5]); zw.w = pk2(sum[6] * rc - cur[6], sum[7] * rc - cur[7]);
        const bf16x8 zf = __builtin_bit_cast(bf16x8, zw);
#pragma unroll
        for (int nb = 0; nb < 8; ++nb) { const bf16x8 wf = *(const bf16x8*)(PWt + (size_t)(G * 128 + nb * 16 + fr) * 128 + ks * 32 + fq * 8);
            acc[nb] = __builtin_amdgcn_mfma_f32_16x16x32_bf16(wf, zf, acc[nb], 0, 0, 0); }
    }
#pragma unroll
    for (int nb = 0; nb < 8; ++nb) { const int col = G * 128 + nb * 16 + 4 * fq;
        const f32x4 sc = *(const f32x4*)(ps + col); const u32x2 gg = *(const u32x2*)(P + (size_t)tok * PJ + C_GP + col);
        u32x2 o; o.x = pk2(acc[nb][0] * sc[0] * bflo(gg.x), acc[nb][1] * sc[1] * bfhi(gg.x)); o.y = pk2(acc[nb][2] * sc[2] * bflo(gg.y), acc[nb][3] * sc[3] * bfhi(gg.y));
        *(u32x2*)(Y + (size_t)tok * DM + Y_POOL + col) = o; }
}
__device__ __forceinline__ void pool_phase(const bf16u* P, const bf16u* PWt, const float* ps, bf16u* Y, int gw, int NGW, int lane) {
    for (int t = gw; t < MTOK / 16; t += NGW) {
        pool_group<0, 2>(P, PWt, ps, Y, t * 16, lane); pool_group<1, 4>(P, PWt, ps, Y, t * 16, lane);
        pool_group<2, 8>(P, PWt, ps, Y, t * 16, lane); pool_group<3, 16>(P, PWt, ps, Y, t * 16, lane);
    }
}

__device__ __forceinline__ void ln_phase(float* X, const float* g, const float* bta, bf16u* XN, int gw, int NGW, int lane) {
    for (int m = gw; m < MTOK; m += NGW) {
        f32x4* xr = (f32x4*)(X + (size_t)m * DM) + lane;
        f32x4 v[8]; float s = 0.f;
#pragma unroll
        for (int j = 0; j < 8; ++j) { v[j] = xr[64 * j]; s += (v[j][0] + v[j][1]) + (v[j][2] + v[j][3]); }
        const float mean = wave_sum(s) * (1.f / DM); float s2 = 0.f;
#pragma unroll
        for (int j = 0; j < 8; ++j) { v[j] = v[j] - mean; s2 += (v[j][0] * v[j][0] + v[j][1] * v[j][1]) + (v[j][2] * v[j][2] + v[j][3] * v[j][3]); }
        const float rstd = 1.f / sqrtf(wave_sum(s2) * (1.f / DM) + LN_EPS);
        u32x2* o8 = (u32x2*)(XN + (size_t)m * DM) + lane;
#pragma unroll
        for (int j = 0; j < 8; ++j) { const f32x4 gg = ((const f32x4*)g)[64 * j + lane], bb = ((const f32x4*)bta)[64 * j + lane];
            const f32x4 o = v[j] * rstd * gg + bb; xr[64 * j] = o;
            u32x2 w; w.x = pk2(o[0], o[1]); w.y = pk2(o[2], o[3]); o8[64 * j] = w; }
    }
}

__device__ __forceinline__ void attn_phase(char* lds, const bf16u* P, bf16u* Y, const float* LF, int vcu) {
    using namespace att;
    int tid = threadIdx.x; asm volatile("" : "+v"(tid));
    const int lane = tid & 63, wid = tid >> 6;
    const int bh = vcu >> 2, s4 = vcu & 3, b = bh >> 3, h = bh & 7;
    {
        const float* lf = LF + (size_t)bh * SEQ + 8 * tid;
        const f32x4 a = *(const f32x4*)lf, c = *(const f32x4*)(lf + 4);
        float v0 = a[0], v1 = v0 + a[1], v2 = v1 + a[2], v3 = v2 + a[3], v4 = v3 + c[0], v5 = v4 + c[1], v6 = v5 + c[2], v7 = v6 + c[3];
        float incl = v7;
#pragma unroll
        for (int o = 1; o < 64; o <<= 1) { const float t = __shfl_up(incl, o); if (lane >= o) incl += t; }
        float* sc = (float*)(lds + SCAN_OFF);
        if (lane == 63) sc[wid] = incl;
        __syncthreads();
        float woff = 0.f;
#pragma unroll
        for (int w = 0; w < 8; ++w) if (w < wid) woff += sc[w];
        const float ex = woff + incl - v7; const float ns = -1.0f / SCALE;
        f32x4* kb = (f32x4*)(lds + KB_OFF) + 2 * tid;
        kb[0] = (f32x4){(ex + v0) * ns, (ex + v1) * ns, (ex + v2) * ns, (ex + v3) * ns};
        kb[1] = (f32x4){(ex + v4) * ns, (ex + v5) * ns, (ex + v6) * ns, (ex + v7) * ns};
        __syncthreads();
    }
    const bf16* Pb = (const bf16*)P + (size_t)b * SEQ * PJ + h * 128; bf16* Yb = (bf16*)Y + (size_t)b * SEQ * DM + Y_ATT + h * 128;
    const int W = 1 << 30;
#define QBOF(i) ((i) == 0 ? 15 - s4 : (i) == 1 ? 8 + s4 : (i) == 2 ? 7 - s4 : s4)
#define MKREF(r, qb) do { (r).Q = Pb + (size_t)(qb) * QB * PJ + C_Q; (r).K = Pb + C_K; (r).V = Pb + C_V; (r).G = Pb + (size_t)(qb) * QB * PJ + C_GA; (r).O = Yb + (size_t)(qb) * QB * DM; (r).P0 = (qb) * QB; } while (0)
    BlockRef<bf16, bf16> cur, nxt; MKREF(cur, QBOF(0));
    Seam<bf16> S;
    causal_swa_prime<bf16, bf16>(cur, W, lds, S);
#pragma unroll 1
    for (int i = 0; i < 4; ++i) {
        if (i < 3) { const int qn = QBOF(i + 1); MKREF(nxt, qn); } else nxt = cur;
        causal_swa_block<bf16, bf16>(cur, nxt, SEQ, W, lds, S);
        cur = nxt;
    }
#undef QBOF
#undef MKREF
}

__global__ void __launch_bounds__(NWAVES * 64, 2) hybrid_fwd(Args a) {
    extern __shared__ __attribute__((aligned(16))) unsigned char lds[];
    const int tid = threadIdx.x, lane = tid & 63, wave = __builtin_amdgcn_readfirstlane(tid >> 6);
    const int G = gridDim.x, bx = blockIdx.x; const int vcu = (G % 8 == 0) ? (bx % 8) * (G / 8) + bx / 8 : bx;
    const int gw = vcu * NWAVES + wave, NGW = G * NWAVES;
    bf16u* WinT = (bf16u*)(a.ws + WS_WIN); bf16u* WoutT = (bf16u*)(a.ws + WS_WOUT); bf16u* Wfg = (bf16u*)(a.ws + WS_WFG); bf16u* PWt = (bf16u*)(a.ws + WS_PWT);
    float* LF = (float*)(a.ws + WS_LF); bf16u* XN = (bf16u*)(a.ws + WS_XN); bf16u* PROJ = (bf16u*)(a.ws + WS_PROJ); bf16u* Y = (bf16u*)(a.ws + WS_Y);
    const int lo = a.ph_lo, hi = a.ph_hi;
#define IN(k) (lo <= (k) && (k) < hi)
#if MK_MULTI_LAUNCH
#define SEAM(k) do { } while (0)
#else
#define SEAM(k) do { if (IN(k) && IN((k) + 1)) { __syncthreads(); cg::this_grid().sync(); } } while (0)
#endif
#define OPQ() int ln_ = lane, gw_ = gw; asm volatile("" : "+v"(ln_)); asm volatile("" : "+s"(gw_))
    if (IN(0)) { OPQ(); prologue_phase(a, (LAS unsigned char*)lds, gw_, NGW, wave, ln_); }
    SEAM(0);
#pragma unroll 1
    for (int l = 0; l < DEPTH; ++l) {
        const int p = 1 + 4 * l;
        if (IN(p)) {
            pg8::Gemm g{XN, WinT + (size_t)l * PJ * DM, MTOK, PJ, DM}; pg8::StaticOrder S; S.init(MTOK, PJ, G, bx);
            pg8::EpiProj E{PROJ, PJ};
            pg8::gemm_phase<pg8::EpiProj, pg8::StaticOrder, true, true>((LAS unsigned char*)lds, g, S, E);
            { OPQ(); fg_phase(XN, Wfg + (size_t)l * 8 * DM, a.b_f + l * NHEAD, LF, gw_, NGW, ln_); }
        }
        SEAM(p);
        if (IN(p + 1)) {
            for (int v = vcu; v < 256; v += G) attn_phase((char*)lds, PROJ, Y, LF, v);
            { OPQ(); conv_phase(PROJ, a.conv_w + (size_t)l * 3 * 512, Y, gw_, NGW, ln_); }
            { OPQ(); pool_phase(PROJ, PWt + (size_t)l * 4 * 16384, a.pool_scale + (size_t)l * 512, Y, gw_, NGW, ln_); }
        }
        SEAM(p + 1);
        if (IN(p + 2)) {
            pg8::Gemm g{Y, WoutT + (size_t)l * DM * DM, MTOK, DM, DM}; pg8::StaticOrder S; S.init(MTOK, DM, G, bx);
            pg8::EpiRes E{l == 0 ? a.x : a.out, a.out, DM, ALPHA};
            pg8::gemm_phase<pg8::EpiRes, pg8::StaticOrder, true, true>((LAS unsigned char*)lds, g, S, E);
        }
        SEAM(p + 2);
        if (IN(p + 3)) { OPQ(); ln_phase(a.out, a.ln_g + (size_t)l * DM, a.ln_b + (size_t)l * DM, XN, gw_, NGW, ln_); }
        SEAM(p + 3);
    }
#undef IN
#undef SEAM
}

extern "C" void kernel_launch(void* const* d_in, const int* in_sizes, int n_in, void* d_out, int out_size, void* d_ws, size_t ws_size, hipStream_t stream) {
    static int grid = 0;
    if (grid == 0) {
        if (n_in != 9 || in_sizes[0] != MTOK * DM || out_size != MTOK * DM || ws_size < WS_END) { fprintf(stderr, "kernel_launch: unexpected shapes (n_in %d, in0 %d, out %d, ws %zu)\n", n_in, n_in > 0 ? in_sizes[0] : -1, out_size, ws_size); grid = -1; return; }
        int dev = 0, cus = 0, per_cu = 0;
        (void)hipGetDevice(&dev); (void)hipDeviceGetAttribute(&cus, hipDeviceAttributeMultiprocessorCount, dev);
        if (hipFuncSetAttribute((const void*)hybrid_fwd, hipFuncAttributeMaxDynamicSharedMemorySize, LDS_BYTES) != hipSuccess) { fprintf(stderr, "kernel_launch: hipFuncSetAttribute failed\n"); grid = -1; return; }
        (void)hipOccupancyMaxActiveBlocksPerMultiprocessor(&per_cu, (const void*)hybrid_fwd, NWAVES * 64, LDS_BYTES);
        (void)hipGetLastError();
        if (per_cu < 1) per_cu = 1;
        grid = cus > 0 ? cus : 256;
    }
    if (grid < 0) return;
    Args a{};
    a.x = (const float*)d_in[0]; a.w_in = (const float*)d_in[1]; a.b_f = (const float*)d_in[2]; a.conv_w = (const float*)d_in[3]; a.pool_w = (const float*)d_in[4];
    a.pool_scale = (const float*)d_in[5]; a.w_out = (const float*)d_in[6]; a.ln_g = (const float*)d_in[7]; a.ln_b = (const float*)d_in[8];
    a.out = (float*)d_out; a.ws = (unsigned char*)d_ws;
    constexpr int NPH = 1 + 4 * DEPTH;
#if MK_MULTI_LAUNCH
    for (int ph = 0; ph < NPH; ++ph) { a.ph_lo = ph; a.ph_hi = ph + 1; hipLaunchKernelGGL(hybrid_fwd, dim3(grid), dim3(NWAVES * 64), LDS_BYTES, stream, a); }
#else
    a.ph_lo = 0; a.ph_hi = NPH;
    void* args[] = {&a};
    hipError_t e = hipLaunchCooperativeKernel((const void*)hybrid_fwd, dim3(grid), dim3(NWAVES * 64), args, LDS_BYTES, stream);
    if (e != hipSuccess) fprintf(stderr, "cooperative launch failed: %s (grid %d)\n", hipGetErrorString(e), grid);
#endif
}
```
